# Optimizing an MI355X kernel written in HIP

```python
import math
import jax, jax.numpy as jnp
from jax import lax
import numpy as np

D_MODEL = 1024
BATCH = 4
SEQ = 4096
DEPTH = 1

CHUNK = 64
N_PREV_CHUNKS = 8
HEAD_DIM = 64
N_HEADS_A = 8
REL_CLIP = 128
N_HEADS_B = 8
N_KV_B = 2
N_IDX_HEADS = 8
IDX_DIM = 64
TOPK_MAX = 256
Q_BLOCK = 128
ROPE_THETA = 500000.0
ROT_DIM = HEAD_DIM // 4
D_FF = 2816
EPS = 1e-6

WIDTH_A = N_HEADS_A * HEAD_DIM
WIDTH_B = N_HEADS_B * HEAD_DIM
WIDTH_KV_B = N_KV_B * HEAD_DIM
SPLIT_SIZES = (WIDTH_A, WIDTH_A, WIDTH_A,
               WIDTH_B, WIDTH_KV_B, WIDTH_KV_B,
               N_IDX_HEADS * IDX_DIM, IDX_DIM,
               N_IDX_HEADS,
               D_MODEL, D_MODEL)
D_IN = sum(SPLIT_SIZES)

kernel_name = 'hybrid_chunked_relbias_dsa_macaron'


def _rmsnorm(x, g):
    xf = x.astype(jnp.float32)
    y = xf * lax.rsqrt(jnp.mean(xf * xf, axis=-1, keepdims=True) + EPS)
    return (y * g.astype(jnp.float32)).astype(x.dtype)


def _swiglu(x, w_in, w_out):
    gate, up = jnp.split(x @ w_in, 2, axis=-1)
    return (jax.nn.silu(gate) * up) @ w_out


def _rope_tables(seq):
    inv_freq = jnp.power(jnp.float32(ROPE_THETA), -jnp.arange(0, ROT_DIM, 2, dtype=jnp.float32) / ROT_DIM)
    ang = jnp.arange(seq, dtype=jnp.float32)[:, None] * inv_freq[None, :]
    return jnp.cos(ang)[:, None, :], jnp.sin(ang)[:, None, :]


def _partial_rope(t, cos, sin):
    tr = t[..., :ROT_DIM].astype(jnp.float32)
    t1, t2 = tr[..., :ROT_DIM // 2], tr[..., ROT_DIM // 2:]
    rot = jnp.concatenate([t1 * cos - t2 * sin, t2 * cos + t1 * sin], axis=-1)
    return jnp.concatenate([rot.astype(t.dtype), t[..., ROT_DIM:]], axis=-1)


def _mixer_a(q, k, v, rel_bias):
    B, S, H, Dh = q.shape
    nc = S // CHUNK
    band_len = (N_PREV_CHUNKS + 1) * CHUNK
    qc = q.reshape(B, nc, CHUNK, H, Dh)

    def band(t):
        tp = jnp.pad(t, ((0, 0), (N_PREV_CHUNKS * CHUNK, 0), (0, 0), (0, 0)))
        tp = tp.reshape(B, nc + N_PREV_CHUNKS, CHUNK, H, Dh)
        return jnp.concatenate([tp[:, j:j + nc] for j in range(N_PREV_CHUNKS + 1)], axis=2)

    kb, vb = band(k), band(v)
    s = jnp.einsum('bnqhd,bnkhd->bnhqk', qc, kb).astype(jnp.float32) * (Dh ** -0.5)
    qi = jnp.arange(CHUNK)
    kj = jnp.arange(band_len)
    dist = N_PREV_CHUNKS * CHUNK + qi[:, None] - kj[None, :]
    bias = rel_bias[:, jnp.clip(dist, -REL_CLIP, REL_CLIP) + REL_CLIP].astype(jnp.float32)
    key_pos = (jnp.arange(nc)[:, None] - N_PREV_CHUNKS) * CHUNK + kj[None, :]
    valid = (key_pos >= 0)[None, :, None, None, :]
    s = jnp.where(valid, s + bias[None, None], -jnp.inf)
    p = jax.nn.softmax(s, axis=-1).astype(vb.dtype)
    o = jnp.einsum('bnhqk,bnkhd->bnqhd', p, vb)
    return o.reshape(B, S, H * Dh)


def _to_blocks(a):
    B, S = a.shape[:2]
    return jnp.moveaxis(a.reshape((B, S // Q_BLOCK, Q_BLOCK) + a.shape[2:]), 1, 0)


def _mixer_b(q, k, v, q_idx, k_idx, w_idx):
    B, S, H, Dh = q.shape
    G = k.shape[2]
    R = H // G
    topk = min(TOPK_MAX, S // 4)
    nb = S // Q_BLOCK
    key_pos = jnp.arange(S)
    w_scaled = w_idx * (N_IDX_HEADS ** -0.5)

    def one_block(args):
        qb, qib, wb, pos_q = args
        sc = jnp.einsum('bqhd,bsd->bqhs', qib, k_idx).astype(jnp.float32) * (IDX_DIM ** -0.5)
        score = jnp.einsum('bqh,bqhs->bqs', wb.astype(jnp.float32), jax.nn.relu(sc))
        limit = (pos_q // CHUNK + 1) * CHUNK
        adm = key_pos[None, :] < limit[:, None]
        score = jnp.where(adm[None], score, -jnp.inf)
        _, idx = lax.top_k(score, topk)
        sel_ok = idx < limit[None, :, None]
        kg = jax.vmap(lambda t, i: t[i])(k, idx)
        vg = jax.vmap(lambda t, i: t[i])(v, idx)
        qg = qb.reshape(B, Q_BLOCK, G, R, Dh)
        s = jnp.einsum('bqgrd,bqkgd->bqgrk', qg, kg).astype(jnp.float32) * (Dh ** -0.5)
        s = jnp.where(sel_ok[:, :, None, None, :], s, -jnp.inf)
        p = jax.nn.softmax(s, axis=-1).astype(vg.dtype)
        o = jnp.einsum('bqgrk,bqkgd->bqgrd', p, vg)
        return o.reshape(B, Q_BLOCK, H * Dh)

    out = lax.map(one_block, (_to_blocks(q), _to_blocks(q_idx), _to_blocks(w_scaled),
                              key_pos.reshape(nb, Q_BLOCK)))
    return jnp.moveaxis(out, 0, 1).reshape(B, S, H * Dh)


def setup_inputs(seed: int = 0) -> dict:
    key = jax.random.key(seed)
    ks = jax.random.split(key, 16)
    f32 = jnp.float32

    def w(k, shape, fan_in):
        return jax.random.normal(k, shape, f32) * (fan_in ** -0.5)

    def gain(k):
        return 1.0 + 0.02 * jax.random.normal(k, (DEPTH, D_MODEL), f32)

    return {
        'x': jax.random.normal(ks[0], (BATCH, SEQ, D_MODEL), f32),
        'n1_g': gain(ks[1]),
        'ffn1_w_in': w(ks[2], (DEPTH, D_MODEL, 2 * D_FF), D_MODEL),
        'ffn1_w_out': w(ks[3], (DEPTH, D_FF, D_MODEL), D_FF),
        'n2_g': gain(ks[4]),
        'w_in': w(ks[5], (DEPTH, D_MODEL, D_IN), D_MODEL),
        'rel_bias': 0.2 * jax.random.normal(ks[6], (DEPTH, N_HEADS_A, 2 * REL_CLIP + 1), f32),
        'w_branch_a': w(ks[7], (DEPTH, WIDTH_A, D_MODEL), WIDTH_A),
        'w_branch_b': w(ks[8], (DEPTH, WIDTH_B, D_MODEL), WIDTH_B),
        'w_out': w(ks[9], (DEPTH, D_MODEL, D_MODEL), D_MODEL),
        'n3_g': gain(ks[10]),
        'ffn2_w_in': w(ks[11], (DEPTH, D_MODEL, 2 * D_FF), D_MODEL),
        'ffn2_w_out': w(ks[12], (DEPTH, D_FF, D_MODEL), D_FF),
        'nf_g': 1.0 + 0.02 * jax.random.normal(ks[13], (D_MODEL,), f32),
    }


def reference(x, n1_g, ffn1_w_in, ffn1_w_out, n2_g, w_in, rel_bias, w_branch_a, w_branch_b,
              w_out, n3_g, ffn2_w_in, ffn2_w_out, nf_g):
    B, S, _ = x.shape
    cos, sin = _rope_tables(S)
    split_points = list(np.cumsum(SPLIT_SIZES)[:-1])
    for l in range(DEPTH):
        x = x + 0.5 * _swiglu(_rmsnorm(x, n1_g[l]), ffn1_w_in[l], ffn1_w_out[l])
        h = _rmsnorm(x, n2_g[l])
        qa, ka, va, qb, kb, vb, qi, ki, wi, ga, gb = jnp.split(h @ w_in[l], split_points, axis=-1)
        qa = qa.reshape(B, S, N_HEADS_A, HEAD_DIM)
        ka = ka.reshape(B, S, N_HEADS_A, HEAD_DIM)
        va = va.reshape(B, S, N_HEADS_A, HEAD_DIM)
        qb = _partial_rope(qb.reshape(B, S, N_HEADS_B, HEAD_DIM), cos, sin)
        kb = _partial_rope(kb.reshape(B, S, N_KV_B, HEAD_DIM), cos, sin)
        vb = vb.reshape(B, S, N_KV_B, HEAD_DIM)
        qi = _partial_rope(qi.reshape(B, S, N_IDX_HEADS, IDX_DIM), cos, sin)
        ki = _partial_rope(ki.reshape(B, S, 1, IDX_DIM), cos, sin)[:, :, 0]
        o_a = _mixer_a(qa, ka, va, rel_bias[l])
        o_b = _mixer_b(qb, kb, vb, qi, ki, wi)
        merged = jax.nn.sigmoid(ga) * (o_a @ w_branch_a[l]) + jax.nn.sigmoid(gb) * (o_b @ w_branch_b[l])
        x = x + merged @ w_out[l]
        x = x + 0.5 * _swiglu(_rmsnorm(x, n3_g[l]), ffn2_w_in[l], ffn2_w_out[l])
    return _rmsnorm(x, nf_g)
```

```cpp
#include <hip/hip_runtime.h>
#include <cstdint>
#include <cmath>

namespace nv {
constexpr int D = 1024, NB = 4, S = 4096, FF = 2816, DIN = 4936;
constexpr int C_QA = 0, C_KA = 512, C_VA = 1024, C_QB = 1536, C_KB = 2048, C_VB = 2176, C_QI = 2304, C_KI = 2816, C_WI = 2880, C_GA = 2888, C_GB = 3912;

__global__ __launch_bounds__(256) void gemm_f32(const float* __restrict__ A, int lda, const float* __restrict__ Bm, int ldb, float* __restrict__ C, int ldc, int N, int K) {
    __shared__ float As[16][68];
    __shared__ float Bs[16][68];
    const int tid = threadIdx.x, tx = tid & 15, ty = tid >> 4;
    const int m0 = blockIdx.y * 64, n0 = blockIdx.x * 64;
    float acc[4][4];
#pragma unroll
    for (int i = 0; i < 4; ++i)
#pragma unroll
        for (int j = 0; j < 4; ++j) acc[i][j] = 0.f;
    const int am = tid >> 2, ak = (tid & 3) * 4;
    const int bk = tid >> 4, bn = (tid & 15) * 4;
    for (int k0 = 0; k0 < K; k0 += 16) {
        const float4 av = *(const float4*)(A + (size_t)(m0 + am) * lda + k0 + ak);
        float4 bv = make_float4(0.f, 0.f, 0.f, 0.f);
        if (n0 + bn < N) bv = *(const float4*)(Bm + (size_t)(k0 + bk) * ldb + n0 + bn);
        __syncthreads();
        As[ak + 0][am] = av.x; As[ak + 1][am] = av.y; As[ak + 2][am] = av.z; As[ak + 3][am] = av.w;
        Bs[bk][bn + 0] = bv.x; Bs[bk][bn + 1] = bv.y; Bs[bk][bn + 2] = bv.z; Bs[bk][bn + 3] = bv.w;
        __syncthreads();
#pragma unroll
        for (int k = 0; k < 16; ++k) {
            float a[4], b[4];
#pragma unroll
            for (int i = 0; i < 4; ++i) a[i] = As[k][ty * 4 + i];
#pragma unroll
            for (int j = 0; j < 4; ++j) b[j] = Bs[k][tx * 4 + j];
#pragma unroll
            for (int i = 0; i < 4; ++i)
#pragma unroll
                for (int j = 0; j < 4; ++j) acc[i][j] = fmaf(a[i], b[j], acc[i][j]);
        }
    }
    if (n0 + tx * 4 < N) {
#pragma unroll
        for (int i = 0; i < 4; ++i)
            *(float4*)(C + (size_t)(m0 + ty * 4 + i) * ldc + n0 + tx * 4) = make_float4(acc[i][0], acc[i][1], acc[i][2], acc[i][3]);
    }
}

__device__ __forceinline__ float wave_sum(float v) {
#pragma unroll
    for (int o = 1; o < 64; o <<= 1) v += __shfl_xor(v, o);
    return v;
}
__device__ __forceinline__ float wave_max(float v) {
#pragma unroll
    for (int o = 1; o < 64; o <<= 1) v = fmaxf(v, __shfl_xor(v, o));
    return v;
}

__global__ __launch_bounds__(256) void rmsnorm_k(const float* x, const float* __restrict__ g, float* out) {
    const int row = blockIdx.x * 4 + (threadIdx.x >> 6), lane = threadIdx.x & 63;
    const float4* xr = (const float4*)(x + (size_t)row * D);
    float4 v[4]; float s = 0.f;
#pragma unroll
    for (int j = 0; j < 4; ++j) { v[j] = xr[lane + 64 * j]; s += v[j].x * v[j].x + v[j].y * v[j].y + v[j].z * v[j].z + v[j].w * v[j].w; }
    s = wave_sum(s);
    const float r = 1.0f / sqrtf(s * (1.0f / D) + 1e-6f);
    float4* o = (float4*)(out + (size_t)row * D);
    const float4* gr = (const float4*)g;
#pragma unroll
    for (int j = 0; j < 4; ++j) { const float4 gg = gr[lane + 64 * j]; o[lane + 64 * j] = make_float4(v[j].x * r * gg.x, v[j].y * r * gg.y, v[j].z * r * gg.z, v[j].w * r * gg.w); }
}

__global__ void swiglu_k(const float* __restrict__ U, float* __restrict__ H, int rows) {
    const size_t i = (size_t)blockIdx.x * blockDim.x + threadIdx.x;
    if (i >= (size_t)rows * FF) return;
    const size_t m = i / FF; const int j = (int)(i % FF);
    const float g = U[m * (2 * FF) + j], u = U[m * (2 * FF) + FF + j];
    H[i] = (g / (1.0f + expf(-g))) * u;
}

__global__ void axpy_k(float* __restrict__ X, const float* __restrict__ Y, float alpha, size_t n) {
    const size_t i = (size_t)blockIdx.x * blockDim.x + threadIdx.x;
    if (i < n) X[i] += alpha * Y[i];
}

__global__ void rope_k(float* __restrict__ P) {
    const int i = blockIdx.x * blockDim.x + threadIdx.x;
    if (i >= S * 19 * 8) return;
    const int j = i & 7, slot = (i >> 3) % 19, s = i / (19 * 8);
    int col;
    if (slot < 8) col = C_QB + slot * 64; else if (slot < 10) col = C_KB + (slot - 8) * 64; else if (slot < 18) col = C_QI + (slot - 10) * 64; else col = C_KI;
    const float inv = powf(500000.0f, -(float)(2 * j) / 16.0f);
    const float ang = (float)s * inv;
    const float c = cosf(ang), sn = sinf(ang);
    float* p = P + (size_t)s * DIN + col;
    const float t1 = p[j], t2 = p[j + 8];
    p[j] = t1 * c - t2 * sn; p[j + 8] = t2 * c + t1 * sn;
}

__global__ __launch_bounds__(64) void mixer_a_k(const float* __restrict__ P, const float* __restrict__ rel_bias, float* __restrict__ OA) {
    __shared__ float qs[64];
    __shared__ float sc[576];
    const int s = blockIdx.x >> 3, h = blockIdx.x & 7, lane = threadIdx.x;
    qs[lane] = P[(size_t)s * DIN + C_QA + h * 64 + lane];
    __syncthreads();
    const int n = s >> 6; const int k_lo = (n - 8) * 64 < 0 ? 0 : (n - 8) * 64, k_hi = (n + 1) * 64;
    float mx = -INFINITY;
    for (int key = k_lo + lane; key < k_hi; key += 64) {
        const float4* kr = (const float4*)(P + (size_t)key * DIN + C_KA + h * 64);
        float d = 0.f;
#pragma unroll
        for (int q = 0; q < 16; ++q) { const float4 kv = kr[q]; d += qs[4 * q] * kv.x + qs[4 * q + 1] * kv.y + qs[4 * q + 2] * kv.z + qs[4 * q + 3] * kv.w; }
        int dist = s - key; dist = dist < -128 ? -128 : (dist > 128 ? 128 : dist);
        const float v = d * 0.125f + rel_bias[h * 257 + dist + 128];
        sc[key - k_lo] = v; mx = fmaxf(mx, v);
    }
    mx = wave_max(mx);
    __syncthreads();
    float sum = 0.f;
    for (int key = k_lo + lane; key < k_hi; key += 64) { const float p = expf(sc[key - k_lo] - mx); sc[key - k_lo] = p; sum += p; }
    sum = wave_sum(sum);
    __syncthreads();
    float o = 0.f;
    for (int key = k_lo; key < k_hi; ++key) o += sc[key - k_lo] * P[(size_t)key * DIN + C_VA + h * 64 + lane];
    OA[(size_t)s * 512 + h * 64 + lane] = o / sum;
}

__global__ __launch_bounds__(256) void idx_score_k(const float* __restrict__ P, float* __restrict__ SC) {
    __shared__ float qi[8][64];
    __shared__ float w[8];
    const int s = blockIdx.x, tid = threadIdx.x;
    for (int i = tid; i < 512; i += 256) qi[i >> 6][i & 63] = P[(size_t)s * DIN + C_QI + i];
    if (tid < 8) w[tid] = P[(size_t)s * DIN + C_WI + tid] * 0.35355339059327373f;
    __syncthreads();
    const int limit = ((s >> 6) + 1) * 64;
    for (int key = tid; key < limit; key += 256) {
        const float4* kr = (const float4*)(P + (size_t)key * DIN + C_KI);
        float acc[8];
#pragma unroll
        for (int h = 0; h < 8; ++h) acc[h] = 0.f;
#pragma unroll 4
        for (int q = 0; q < 16; ++q) {
            const float4 kv = kr[q];
#pragma unroll
            for (int h = 0; h < 8; ++h) acc[h] += qi[h][4 * q] * kv.x + qi[h][4 * q + 1] * kv.y + qi[h][4 * q + 2] * kv.z + qi[h][4 * q + 3] * kv.w;
        }
        float sc = 0.f;
#pragma unroll
        for (int h = 0; h < 8; ++h) sc += w[h] * fmaxf(acc[h] * 0.125f, 0.f);
        SC[(size_t)s * S + key] = sc + 0.0f;
    }
}

__device__ __forceinline__ unsigned f2u(float f) { const unsigned u = __float_as_uint(f); return (u & 0x80000000u) ? ~u : (u | 0x80000000u); }

__global__ __launch_bounds__(256) void select_k(const float* __restrict__ SC, unsigned char* __restrict__ FL) {
    __shared__ unsigned hist[256];
    __shared__ unsigned sh_prefix, sh_k;
    const int s = blockIdx.x, tid = threadIdx.x;
    const int limit = ((s >> 6) + 1) * 64;
    const float* row = SC + (size_t)s * S; unsigned char* fl = FL + (size_t)s * S;
    if (limit <= 256) { for (int key = tid; key < limit; key += 256) fl[key] = 1; return; }
    unsigned prefix = 0u, mask = 0u, kth = 256u;
    for (int shift = 24; shift >= 0; shift -= 8) {
        hist[tid] = 0u;
        __syncthreads();
        for (int key = tid; key < limit; key += 256) { const unsigned u = f2u(row[key]); if ((u & mask) == prefix) atomicAdd(&hist[(u >> shift) & 255u], 1u); }
        __syncthreads();
        if (tid == 0) {
            unsigned cum = 0u; int b = 255;
            for (; b > 0; --b) { if (cum + hist[b] >= kth) break; cum += hist[b]; }
            sh_prefix = prefix | ((unsigned)b << shift); sh_k = kth - cum;
        }
        __syncthreads();
        prefix = sh_prefix; kth = sh_k; mask |= 0xFFu << shift;
        __syncthreads();
    }
    for (int key = tid; key < limit; key += 256) { const unsigned u = f2u(row[key]); if (u != prefix) fl[key] = (u > prefix) ? 1 : 0; }
    if (tid == 0) { unsigned c = 0u; for (int key = 0; key < limit; ++key) { if (f2u(row[key]) == prefix) { fl[key] = (c < kth) ? 1 : 0; ++c; } } }
}

__global__ __launch_bounds__(64) void mixer_b_k(const float* __restrict__ P, const unsigned char* __restrict__ FL, float* __restrict__ OB) {
    __shared__ float qs[64];
    __shared__ float sc[4096];
    const int s = blockIdx.x >> 3, h = blockIdx.x & 7, lane = threadIdx.x, g = h >> 2;
    qs[lane] = P[(size_t)s * DIN + C_QB + h * 64 + lane];
    __syncthreads();
    const int limit = ((s >> 6) + 1) * 64;
    const unsigned char* fl = FL + (size_t)s * S;
    float mx = -INFINITY;
    for (int key = lane; key < limit; key += 64) {
        float v = -INFINITY;
        if (fl[key]) {
            const float4* kr = (const float4*)(P + (size_t)key * DIN + C_KB + g * 64);
            float d = 0.f;
#pragma unroll
            for (int q = 0; q < 16; ++q) { const float4 kv = kr[q]; d += qs[4 * q] * kv.x + qs[4 * q + 1] * kv.y + qs[4 * q + 2] * kv.z + qs[4 * q + 3] * kv.w; }
            v = d * 0.125f;
        }
        sc[key] = v; mx = fmaxf(mx, v);
    }
    mx = wave_max(mx);
    __syncthreads();
    float sum = 0.f;
    for (int key = lane; key < limit; key += 64) { const float p = expf(sc[key] - mx); sc[key] = p; sum += p; }
    sum = wave_sum(sum);
    __syncthreads();
    float o = 0.f;
    for (int key = 0; key < limit; ++key) { const float p = sc[key]; if (p != 0.f) o += p * P[(size_t)key * DIN + C_VB + g * 64 + lane]; }
    OB[(size_t)s * 512 + h * 64 + lane] = o / sum;
}

__global__ void gate_k(const float* __restrict__ P, const float* __restrict__ PA, const float* __restrict__ PB, float* __restrict__ MG) {
    const size_t i = (size_t)blockIdx.x * blockDim.x + threadIdx.x;
    if (i >= (size_t)S * D) return;
    const size_t m = i / D; const int n = (int)(i % D);
    const float ga = P[m * DIN + C_GA + n], gb = P[m * DIN + C_GB + n];
    MG[i] = PA[i] / (1.0f + expf(-ga)) + PB[i] / (1.0f + expf(-gb));
}
}

extern "C" void kernel_launch(void* const* d_in, const int* in_sizes, int n_in, void* d_out, int out_size, void* d_ws, size_t ws_size, hipStream_t stream) {
    using namespace nv;
    const float* x = (const float*)d_in[0];
    const float* n1_g = (const float*)d_in[1];
    const float* ffn1_w_in = (const float*)d_in[2];
    const float* ffn1_w_out = (const float*)d_in[3];
    const float* n2_g = (const float*)d_in[4];
    const float* w_in = (const float*)d_in[5];
    const float* rel_bias = (const float*)d_in[6];
    const float* w_a = (const float*)d_in[7];
    const float* w_b = (const float*)d_in[8];
    const float* w_out = (const float*)d_in[9];
    const float* n3_g = (const float*)d_in[10];
    const float* ffn2_w_in = (const float*)d_in[11];
    const float* ffn2_w_out = (const float*)d_in[12];
    const float* nf_g = (const float*)d_in[13];
    float* out = (float*)d_out;
    char* ws = (char*)d_ws;
    constexpr size_t MiB = 1u << 20;
    float* XN = (float*)(ws + 0);
    float* U = (float*)(ws + 16 * MiB);
    float* Hh = (float*)(ws + 104 * MiB);
    float* Y = (float*)(ws + 148 * MiB);
    float* SC = (float*)(ws + 164 * MiB);
    unsigned char* FL = (unsigned char*)(ws + 228 * MiB);
    float* P = U;
    float* OA = Hh; float* OB = Hh + (size_t)S * 512; float* PB = Hh + (size_t)2 * S * 512;
    float* PA = Y; float* MG = XN;

    hipMemcpyAsync(out, x, (size_t)NB * S * D * sizeof(float), hipMemcpyDeviceToDevice, stream);
    for (int b = 0; b < NB; ++b) {
        float* xr = out + (size_t)b * S * D;
        rmsnorm_k<<<S / 4, 256, 0, stream>>>(xr, n1_g, XN);
        gemm_f32<<<dim3(2 * FF / 64, S / 64), 256, 0, stream>>>(XN, D, ffn1_w_in, 2 * FF, U, 2 * FF, 2 * FF, D);
        swiglu_k<<<(unsigned)(((size_t)S * FF + 255) / 256), 256, 0, stream>>>(U, Hh, S);
        gemm_f32<<<dim3(D / 64, S / 64), 256, 0, stream>>>(Hh, FF, ffn1_w_out, D, Y, D, D, FF);
        axpy_k<<<(unsigned)(((size_t)S * D + 255) / 256), 256, 0, stream>>>(xr, Y, 0.5f, (size_t)S * D);
        rmsnorm_k<<<S / 4, 256, 0, stream>>>(xr, n2_g, XN);
        gemm_f32<<<dim3((DIN + 63) / 64, S / 64), 256, 0, stream>>>(XN, D, w_in, DIN, P, DIN, DIN, D);
        rope_k<<<(S * 19 * 8 + 255) / 256, 256, 0, stream>>>(P);
        mixer_a_k<<<S * 8, 64, 0, stream>>>(P, rel_bias, OA);
        idx_score_k<<<S, 256, 0, stream>>>(P, SC);
        select_k<<<S, 256, 0, stream>>>(SC, FL);
        mixer_b_k<<<S * 8, 64, 0, stream>>>(P, FL, OB);
        gemm_f32<<<dim3(D / 64, S / 64), 256, 0, stream>>>(OA, 512, w_a, D, PA, D, D, 512);
        gemm_f32<<<dim3(D / 64, S / 64), 256, 0, stream>>>(OB, 512, w_b, D, PB, D, D, 512);
        gate_k<<<(unsigned)(((size_t)S * D + 255) / 256), 256, 0, stream>>>(P, PA, PB, MG);
        gemm_f32<<<dim3(D / 64, S / 64), 256, 0, stream>>>(MG, D, w_out, D, Y, D, D, D);
        axpy_k<<<(unsigned)(((size_t)S * D + 255) / 256), 256, 0, stream>>>(xr, Y, 1.0f, (size_t)S * D);
        rmsnorm_k<<<S / 4, 256, 0, stream>>>(xr, n3_g, XN);
        gemm_f32<<<dim3(2 * FF / 64, S / 64), 256, 0, stream>>>(XN, D, ffn2_w_in, 2 * FF, U, 2 * FF, 2 * FF, D);
        swiglu_k<<<(unsigned)(((size_t)S * FF + 255) / 256), 256, 0, stream>>>(U, Hh, S);
        gemm_f32<<<dim3(D / 64, S / 64), 256, 0, stream>>>(Hh, FF, ffn2_w_out, D, Y, D, D, FF);
        axpy_k<<<(unsigned)(((size_t)S * D + 255) / 256), 256, 0, stream>>>(xr, Y, 0.5f, (size_t)S * D);
        rmsnorm_k<<<S / 4, 256, 0, stream>>>(xr, nf_g, xr);
    }
}
```

```cpp
#include <hip/hip_runtime.h>
#include <cstdio>
#include <cstdint>
#include <cmath>
#define GAS __attribute__((address_space(1)))
#define LAS __attribute__((address_space(3)))
typedef unsigned short bf16;
typedef unsigned v4u __attribute__((ext_vector_type(4)));
typedef float f32x4 __attribute__((ext_vector_type(4)));
typedef short bf16x8 __attribute__((ext_vector_type(8)));
typedef GAS unsigned gu32;
typedef GAS unsigned long long gu64;
#define RLX_AGENT __ATOMIC_RELAXED, __HIP_MEMORY_SCOPE_AGENT
#define LDS_WAIT() asm volatile("s_waitcnt lgkmcnt(0)" ::: "memory")
#define VM_WAIT() asm volatile("s_waitcnt vmcnt(0)" ::: "memory")
__device__ __forceinline__ unsigned long long rt() { return __builtin_amdgcn_s_memrealtime(); }
__device__ __forceinline__ unsigned f2bf(float f) { unsigned u = __builtin_bit_cast(unsigned, f); return (u + 0x7fffu + ((u >> 16) & 1u)) >> 16; }
__device__ __forceinline__ unsigned pk2(float lo, float hi) { return f2bf(lo) | (f2bf(hi) << 16); }

#define XB_TMO      128
#define XB_XCNT(j)  (256  + 64 * (j))
#define XB_XSUB(j)  (1280 + 64 * (j))
#define XB_XGEN(j)  (2304 + 64 * (j))
#define XB_TOP      3328
#define XB_TOPGEN   3392
#define XCD_BAR_WORDS 3456
#define XB_SPIN_CAP (1u << 18)

__device__ __forceinline__ unsigned xb_ld(unsigned* p)              { return __hip_atomic_load(p, __ATOMIC_RELAXED, __HIP_MEMORY_SCOPE_AGENT); }
__device__ __forceinline__ unsigned xb_add(unsigned* p, unsigned v) { return __hip_atomic_fetch_add(p, v, __ATOMIC_RELAXED, __HIP_MEMORY_SCOPE_AGENT); }
__device__ __forceinline__ unsigned xb_xcc_id() { return (unsigned)__builtin_amdgcn_s_getreg((3 << 11) | 20) & 0xFu; }
#define XB_SPIN(cond, bar) do { unsigned _sp = 0; while (cond) { __builtin_amdgcn_s_sleep(1); \
    if ((++_sp & 255u) == 0u) { if (xb_ld(&(bar)[XB_TMO])) break; if (_sp > XB_SPIN_CAP) { atomicAdd(&(bar)[XB_TMO], 1u); break; } } } } while (0)

struct XcdBarrier {
    unsigned* bar; unsigned x;
    volatile LAS unsigned* st;
};

__device__ __forceinline__ XcdBarrier xcd_barrier_post(unsigned* bar, volatile LAS unsigned* st) {
    XcdBarrier b; b.bar = bar; b.x = xb_xcc_id(); b.st = st;
    if (threadIdx.x == 0) (void)xb_add(&bar[XB_XCNT(b.x)], 1u);
    return b;
}
__device__ __forceinline__ void xcd_barrier_complete(unsigned* bar, unsigned x, unsigned& nloc, unsigned& nx) {
    const unsigned G = gridDim.x * gridDim.y * gridDim.z;
    unsigned sum, cnt, mine, sp = 0u;
    for (;;) {
        sum = 0u; cnt = 0u; mine = 0u;
#pragma unroll
        for (unsigned j = 0; j < 16; ++j) { const unsigned c = xb_ld(&bar[XB_XCNT(j)]); sum += c; cnt += (c > 0u) ? 1u : 0u; mine = (j == x) ? c : mine; }
        if (sum == G) break;
        __builtin_amdgcn_s_sleep(1);
        if ((++sp & 255u) == 0u) { if (xb_ld(&bar[XB_TMO])) break; if (sp > XB_SPIN_CAP) { atomicAdd(&bar[XB_TMO], 1u); break; } }
    }
    nloc = mine > 0u ? mine : 1u; nx = cnt > 0u ? cnt : 1u;
}

__device__ __forceinline__ void xcd_barrier(const XcdBarrier& b) {
    asm volatile("s_waitcnt vmcnt(0)" ::: "memory");
    __syncthreads();
    if (threadIdx.x == 0) {
        unsigned* bar = b.bar;
        __builtin_amdgcn_s_waitcnt(0);
        unsigned nloc = b.st[0], nx = b.st[1];
        if (nloc == 0u) { xcd_barrier_complete(bar, b.x, nloc, nx); b.st[0] = nloc; b.st[1] = nx; }
        const unsigned old = xb_add(&bar[XB_XSUB(b.x)], 1u);
        const unsigned gen = old / nloc;
        if (old + 1u == (gen + 1u) * nloc) {
            __builtin_amdgcn_fence(__ATOMIC_RELEASE, "agent");
            asm volatile("s_waitcnt vmcnt(0)" ::: "memory");
            const unsigned og = xb_add(&bar[XB_TOP], 1u);
            const unsigned tg = og / nx;
            if (og + 1u == (tg + 1u) * nx) xb_add(&bar[XB_TOPGEN], 1u);
            else XB_SPIN(xb_ld(&bar[XB_TOPGEN]) == tg, bar);
            __builtin_amdgcn_fence(__ATOMIC_ACQUIRE, "agent");
            xb_add(&bar[XB_XGEN(b.x)], 1u);
            asm volatile("s_waitcnt vmcnt(0)" ::: "memory");
        } else {
            XB_SPIN(xb_ld(&bar[XB_XGEN(b.x)]) == gen, bar);
            __builtin_amdgcn_fence(__ATOMIC_ACQUIRE, "agent");
            asm volatile("s_waitcnt vmcnt(0)" ::: "memory");
        }
    }
    __syncthreads();
}
namespace pg8 {
#define PG8_LAS __attribute__((address_space(3)))
typedef unsigned short bf16_t;
typedef short bf16x8 __attribute__((ext_vector_type(8)));
typedef float f32x4 __attribute__((ext_vector_type(4)));
typedef unsigned u32x4 __attribute__((ext_vector_type(4)));
constexpr int BM = 256, BK = 64, HALF = 128, HTB = HALF * BK * 2  , STAGE_BYTES = 8 * HTB, NXCD = 8, WGM = 8;

__host__ __device__ __forceinline__ int lds_byte(int r, int c) { const int st = (r >> 4) * 2 + (c >> 5), rr = r & 15, cc = c & 31, ob = rr * 64 + cc * 2; return st * 1024 + (ob ^ (((ob >> 9) & 1) << 5)); }
__host__ __device__ __forceinline__ void stage_rc(int b, int& R, int& C) { const int st = b / 1024, sb = b % 1024, swz = sb ^ (((sb >> 9) & 1) << 5); R = (st >> 1) * 16 + swz / 64; C = (st & 1) * 32 + (swz % 64) / 2; }
__host__ __device__ __forceinline__ int perm32(int rho) { const int n = rho >> 4, i = rho & 15; return 8 * (i >> 2) + 4 * n + (i & 3); }

struct Unit { int pm, pn; };
struct Gemm { const bf16_t* A; const bf16_t* Bt; int M, N, K; };

struct StaticOrder {
    int nM, nN, nwg, G, c;
    __host__ __device__ void init(int M, int N, int G_, int c_) { nM = M / BM; nN = N / BM; nwg = nM * nN; G = G_; c = c_; }
    __host__ __device__ bool next(int i, Unit& u) const {
        const long L = (long)i * G + c; if (L >= nwg) return false;
        int wgid = (int)L; { const int q = nwg / NXCD, r = nwg % NXCD, xcd = wgid % NXCD, off = wgid / NXCD; wgid = (xcd < r ? xcd * (q + 1) : r * (q + 1) + (xcd - r) * q) + off; }
        const int nig = WGM * nN, gid = wgid / nig, fm = gid * WGM, gsz = (nM - fm) < WGM ? (nM - fm) : WGM;
        u.pm = fm + ((wgid % nig) % gsz); u.pn = (wgid % nig) / gsz; return true;
    }
    __device__ __forceinline__ void a_ready(const Unit&) const {}
    __device__ __forceinline__ void done(const Unit&) const {}
};

typedef float cv_f32x2_t __attribute__((ext_vector_type(2))); typedef __bf16 cv_bf16x2_t __attribute__((ext_vector_type(2)));
__device__ __forceinline__ unsigned cvt_pk_bf16(float lo, float hi) { const cv_f32x2_t v = {lo, hi}; const cv_bf16x2_t b = __builtin_convertvector(v, cv_bf16x2_t); return __builtin_bit_cast(unsigned, b); }
__device__ __forceinline__ float bf_lo(unsigned w) { return __uint_as_float(w << 16); }
__device__ __forceinline__ float bf_hi(unsigned w) { return __uint_as_float(w & 0xffff0000u); }
constexpr float LOG2E = 1.4426950408889634f;
__device__ __forceinline__ float fast_sigmoid(float v) { return __builtin_amdgcn_rcpf(1.0f + __builtin_amdgcn_exp2f(-v * LOG2E)); }
__device__ __forceinline__ float row_rstd(const float* ssq, int row) {
    const f32x4* p = (const f32x4*)(ssq + (size_t)row * 16);
    const f32x4 a = p[0], b = p[1], c = p[2], d = p[3];
    const float s = (((a[0] + a[1]) + (a[2] + a[3])) + ((b[0] + b[1]) + (b[2] + b[3]))) + (((c[0] + c[1]) + (c[2] + c[3])) + ((d[0] + d[1]) + (d[2] + d[3])));
    return __builtin_amdgcn_rsqf(s * (1.0f / 1024.0f) + 1e-6f);
}

struct EpiSwiglu {
    static constexpr bool PERM = true, AFTER_DRAIN = false, HAS_MID = false;
    bf16_t* H; const float* ssq; const PG8_LAS float* rl; int rl_pm;
    __device__ __forceinline__ void operator()(const f32x4 (&acc)[2][2][4][2], const Unit& u, int wr, int wc, int fr, int fq) const {
        const int row0 = u.pm * BM + wr * 64 + fr, col0 = u.pn * 128 + wc * 32 + 8 * fq;
#pragma unroll
        for (int ai = 0; ai < 2; ++ai)
#pragma unroll
            for (int m = 0; m < 4; ++m) {
                const int row = row0 + ai * HALF + m * 16; const float rs = (u.pm == rl_pm) ? rl[row - rl_pm * BM] : row_rstd(ssq, row);
                float hv[8];
#pragma unroll
                for (int n = 0; n < 2; ++n)
#pragma unroll
                    for (int i = 0; i < 4; ++i) { const float g = acc[ai][0][m][n][i] * rs, up = acc[ai][1][m][n][i] * rs; hv[4 * n + i] = g * fast_sigmoid(g) * up; }
                u32x4 w; w.x = cvt_pk_bf16(hv[0], hv[1]); w.y = cvt_pk_bf16(hv[2], hv[3]); w.z = cvt_pk_bf16(hv[4], hv[5]); w.w = cvt_pk_bf16(hv[6], hv[7]);
                *(u32x4*)(H + (size_t)row * 2816 + col0) = w;
            }
    }
};

struct EpiResid {
    static constexpr bool PERM = true, AFTER_DRAIN = false, HAS_MID = false;
    const float* basef; const bf16_t* baseb; bf16_t* xb; float* ssq_out; float alpha;
    __device__ __forceinline__ void operator()(const f32x4 (&acc)[2][2][4][2], const Unit& u, int wr, int wc, int fr, int fq) const {
        const int row0 = u.pm * BM + wr * 64 + fr, col0 = u.pn * BM + wc * 32 + 8 * fq;
#pragma unroll
        for (int ai = 0; ai < 2; ++ai)
#pragma unroll
            for (int m = 0; m < 4; ++m) {
                const int row = row0 + ai * HALF + m * 16; float ss = 0.f;
#pragma unroll
                for (int bj = 0; bj < 2; ++bj) {
                    const size_t off = (size_t)row * 1024 + col0 + bj * HALF;
                    f32x4 b0, b1;
                    if (basef) { b0 = *(const f32x4*)(basef + off); b1 = *(const f32x4*)(basef + off + 4); }
                    else { const u32x4 w = *(const u32x4*)(baseb + off); b0 = (f32x4){bf_lo(w.x), bf_hi(w.x), bf_lo(w.y), bf_hi(w.y)}; b1 = (f32x4){bf_lo(w.z), bf_hi(w.z), bf_lo(w.w), bf_hi(w.w)}; }
                    const f32x4 v0 = b0 + acc[ai][bj][m][0] * alpha, v1 = b1 + acc[ai][bj][m][1] * alpha;
                    ss += ((v0[0] * v0[0] + v0[1] * v0[1]) + (v0[2] * v0[2] + v0[3] * v0[3])) + ((v1[0] * v1[0] + v1[1] * v1[1]) + (v1[2] * v1[2] + v1[3] * v1[3]));
                    u32x4 w; w.x = cvt_pk_bf16(v0[0], v0[1]); w.y = cvt_pk_bf16(v0[2], v0[3]); w.z = cvt_pk_bf16(v1[0], v1[1]); w.w = cvt_pk_bf16(v1[2], v1[3]); *(u32x4*)(xb + off) = w;
                }
                ss += __shfl_xor(ss, 16); ss += __shfl_xor(ss, 32);
                if (fq == 0) ssq_out[(size_t)row * 16 + u.pn * 4 + wc] = ss;
            }
    }
};

struct EpiResidF {
    static constexpr bool PERM = true, AFTER_DRAIN = false, HAS_MID = false;
    const bf16_t* base; float* out; float* ssq_out; float alpha;
    __device__ __forceinline__ void operator()(const f32x4 (&acc)[2][2][4][2], const Unit& u, int wr, int wc, int fr, int fq) const {
        const int row0 = u.pm * BM + wr * 64 + fr, col0 = u.pn * BM + wc * 32 + 8 * fq;
#pragma unroll
        for (int ai = 0; ai < 2; ++ai)
#pragma unroll
            for (int m = 0; m < 4; ++m) {
                const int row = row0 + ai * HALF + m * 16; float ss = 0.f;
#pragma unroll
                for (int bj = 0; bj < 2; ++bj) {
                    const size_t off = (size_t)row * 1024 + col0 + bj * HALF;
                    const u32x4 w = *(const u32x4*)(base + off);
                    const f32x4 b0 = (f32x4){bf_lo(w.x), bf_hi(w.x), bf_lo(w.y), bf_hi(w.y)}, b1 = (f32x4){bf_lo(w.z), bf_hi(w.z), bf_lo(w.w), bf_hi(w.w)};
                    const f32x4 v0 = b0 + acc[ai][bj][m][0] * alpha, v1 = b1 + acc[ai][bj][m][1] * alpha;
                    *(f32x4*)(out + off) = v0; *(f32x4*)(out + off + 4) = v1;
                    ss += ((v0[0] * v0[0] + v0[1] * v0[1]) + (v0[2] * v0[2] + v0[3] * v0[3])) + ((v1[0] * v1[0] + v1[1] * v1[1]) + (v1[2] * v1[2] + v1[3] * v1[3]));
                }
                ss += __shfl_xor(ss, 16); ss += __shfl_xor(ss, 32);
                if (fq == 0) ssq_out[(size_t)row * 16 + u.pn * 4 + wc] = ss;
            }
    }
};

struct ProjOut { bf16_t* QAB; bf16_t* KA; bf16_t* VA; bf16_t* KB; bf16_t* VB; bf16_t* QI; bf16_t* KI; float* WI; bf16_t* RAT; bf16_t* SGB; const float* rope; };
constexpr float QSCALE = 0.125f * LOG2E;
constexpr float WSCALE = 0.35355339059327373f * 0.125f;
struct EpiProj {
    static constexpr bool PERM = true, AFTER_DRAIN = false, HAS_MID = false;
    ProjOut o; const float* ssq; const PG8_LAS float* rl; int rl_pm;
    __device__ __forceinline__ void operator()(const f32x4 (&acc)[2][2][4][2], const Unit& u, int wr, int wc, int fr, int fq) const {
        const int row0 = u.pm * BM + wr * 64 + fr; const int pn = u.pn;
        if (pn >= 12) {
            const int col = 128 * (pn - 12) + wc * 32 + 8 * fq;
#pragma unroll
            for (int ai = 0; ai < 2; ++ai)
#pragma unroll
                for (int m = 0; m < 4; ++m) {
                    const int row = row0 + ai * HALF + m * 16; const float rs = (u.pm == rl_pm) ? rl[row - rl_pm * BM] : row_rstd(ssq, row);
                    float rt[8], sb[8];
#pragma unroll
                    for (int n = 0; n < 2; ++n)
#pragma unroll
                        for (int i = 0; i < 4; ++i) {
                            const float ea = __builtin_amdgcn_exp2f(-acc[ai][0][m][n][i] * rs * LOG2E), eb = fminf(__builtin_amdgcn_exp2f(-acc[ai][1][m][n][i] * rs * LOG2E), 1e30f);
                            rt[4 * n + i] = (1.0f + eb) * __builtin_amdgcn_rcpf(1.0f + ea); sb[4 * n + i] = __builtin_amdgcn_rcpf(1.0f + eb);
                        }
                    u32x4 w; w.x = cvt_pk_bf16(rt[0], rt[1]); w.y = cvt_pk_bf16(rt[2], rt[3]); w.z = cvt_pk_bf16(rt[4], rt[5]); w.w = cvt_pk_bf16(rt[6], rt[7]);
                    *(u32x4*)(o.RAT + (size_t)row * 1024 + col) = w;
                    w.x = cvt_pk_bf16(sb[0], sb[1]); w.y = cvt_pk_bf16(sb[2], sb[3]); w.z = cvt_pk_bf16(sb[4], sb[5]); w.w = cvt_pk_bf16(sb[6], sb[7]);
                    *(u32x4*)(o.SGB + (size_t)row * 1024 + col) = w;
                }
            return;
        }
#pragma unroll
        for (int bj = 0; bj < 2; ++bj) {
            const int j8 = bj * HALF + wc * 32 + 8 * fq;
            bf16_t* dst = nullptr; int pitch = 0, col = 0, lay = 0, hh = 0, d0 = 0; bool rope_t = false, wi = false; float scale = 1.0f;
            if (pn < 2)       { dst = o.QAB; pitch = 1024; col = 256 * pn + j8; scale = QSCALE; }
            else if (pn < 4)  { dst = o.KA; lay = 1; col = 256 * (pn - 2) + j8; hh = col >> 6; d0 = col & 63; }
            else if (pn < 6)  { dst = o.VA; lay = 2; col = 256 * (pn - 4) + j8; hh = col >> 6; d0 = col & 63; }
            else if (pn < 8)  { dst = o.QAB; pitch = 1024; col = 512 + 256 * (pn - 6) + j8; scale = QSCALE; rope_t = true; }
            else if (pn == 8) { if (bj == 0) { dst = o.KB; lay = 3; hh = j8 >> 6; d0 = j8 & 63; rope_t = true; } else { dst = o.KB; lay = 4; hh = (j8 - HALF) >> 6; d0 = (j8 - HALF) & 63; } }
            else if (pn < 11) { dst = o.QI; pitch = 512; col = 256 * (pn - 9) + j8; rope_t = true; }
            else if (pn == 11) { if (bj == 0 && wc < 2) { dst = o.KI; lay = 5; d0 = j8; rope_t = true; } else if (bj == 0 && wc == 2) { wi = true; } }
            const bool rope_w = rope_t && ((wc & 1) == 0);
            if (dst == nullptr && !wi) continue;
#pragma unroll
            for (int ai = 0; ai < 2; ++ai)
#pragma unroll
                for (int m = 0; m < 4; ++m) {
                    const int row = row0 + ai * HALF + m * 16; const float rs = (u.pm == rl_pm) ? rl[row - rl_pm * BM] : row_rstd(ssq, row);
                    float v[8];
#pragma unroll
                    for (int n = 0; n < 2; ++n)
#pragma unroll
                        for (int i = 0; i < 4; ++i) v[4 * n + i] = acc[ai][bj][m][n][i] * rs;
                    if (rope_w) {
                        const float* rt = o.rope + (size_t)(row & 4095) * 16 + 4 * (fq & 1);
                        const f32x4 cs = *(const f32x4*)rt, sn = *(const f32x4*)(rt + 8);
                        if (fq < 2) {
#pragma unroll
                            for (int i = 0; i < 4; ++i) { const float a = v[i], b = v[4 + i]; v[i] = a * cs[i] - b * sn[i]; v[4 + i] = b * cs[i] + a * sn[i]; }
                        }
                    }
                    if (wi) {
                        if (fq == 0) { float* wp = o.WI + (size_t)row * 8; *(f32x4*)wp = (f32x4){v[0] * WSCALE, v[1] * WSCALE, v[2] * WSCALE, v[3] * WSCALE}; *(f32x4*)(wp + 4) = (f32x4){v[4] * WSCALE, v[5] * WSCALE, v[6] * WSCALE, v[7] * WSCALE}; }
                    } else {
                        u32x4 w; w.x = cvt_pk_bf16(v[0] * scale, v[1] * scale); w.y = cvt_pk_bf16(v[2] * scale, v[3] * scale); w.z = cvt_pk_bf16(v[4] * scale, v[5] * scale); w.w = cvt_pk_bf16(v[6] * scale, v[7] * scale);
                        size_t eo;
                        const int bq = row >> 12, sq = row & 4095, tq = sq >> 6, kq = sq & 63;
                        if (lay == 0) eo = (size_t)row * pitch + col;
                        else if (lay == 1) eo = ((size_t)((bq * 64 + tq) * 8 + hh) * 8 + (d0 >> 3)) * 512 + kq * 8;
                        else if (lay == 2) eo = ((size_t)((bq * 64 + tq) * 8 + hh) * 8 + (d0 >> 5) * 4 + (kq >> 4)) * 512 + (kq & 15) * 32 + (d0 & 31);
                        else if (lay == 3) eo = (size_t)(bq * 64 + tq) * 16384 + hh * 4096 + (d0 >> 3) * 512 + kq * 8;
                        else if (lay == 4) eo = (size_t)(bq * 64 + tq) * 16384 + 8192 + hh * 4096 + ((d0 >> 5) * 4 + (kq >> 4)) * 512 + (kq & 15) * 32 + (d0 & 31);
                        else eo = ((size_t)(bq * 128 + (sq >> 5)) * 8 + (d0 >> 3)) * 256 + (sq & 31) * 8;
                        *(u32x4*)(dst + eo) = w;
                    }
                }
        }
    }
};

struct EpiGate {
    static constexpr bool PERM = true, AFTER_DRAIN = false, HAS_MID = true;
    const bf16_t* RAT; const bf16_t* SGB; bf16_t* MG;
    __device__ __forceinline__ void scale(f32x4 (&acc)[2][2][4][2], const bf16_t* T, const Unit& u, int wr, int wc, int fr, int fq) const {
        unsigned base = (unsigned)(u.pm * BM + wr * 64 + fr) * 1024u + (unsigned)(u.pn * BM + wc * 32 + 8 * fq);
        asm volatile("" : "+v"(base));
#pragma unroll
        for (int ai = 0; ai < 2; ++ai)
#pragma unroll
            for (int m = 0; m < 4; ++m) {
#pragma unroll
                for (int bj = 0; bj < 2; ++bj) {
                    const unsigned off = base + (unsigned)((ai * HALF + m * 16) * 1024 + bj * HALF);
                    const u32x4 a = *(const u32x4*)(T + off);
                    acc[ai][bj][m][0][0] *= bf_lo(a.x); acc[ai][bj][m][0][1] *= bf_hi(a.x); acc[ai][bj][m][0][2] *= bf_lo(a.y); acc[ai][bj][m][0][3] *= bf_hi(a.y);
                    acc[ai][bj][m][1][0] *= bf_lo(a.z); acc[ai][bj][m][1][1] *= bf_hi(a.z); acc[ai][bj][m][1][2] *= bf_lo(a.w); acc[ai][bj][m][1][3] *= bf_hi(a.w);
                }
                asm volatile("" ::: "memory");
            }
    }
    __device__ __forceinline__ void mid(f32x4 (&acc)[2][2][4][2], const Unit& u, int wr, int wc, int fr, int fq) const { scale(acc, RAT, u, wr, wc, fr, fq); }
    __device__ __forceinline__ void operator()(f32x4 (&acc)[2][2][4][2], const Unit& u, int wr, int wc, int fr, int fq) const {
        scale(acc, SGB, u, wr, wc, fr, fq);
        const int row0 = u.pm * BM + wr * 64 + fr, col0 = u.pn * BM + wc * 32 + 8 * fq;
#pragma unroll
        for (int ai = 0; ai < 2; ++ai)
#pragma unroll
            for (int m = 0; m < 4; ++m)
#pragma unroll
                for (int bj = 0; bj < 2; ++bj) {
                    const size_t off = (size_t)(row0 + ai * HALF + m * 16) * 1024 + col0 + bj * HALF;
                    const f32x4 v0 = acc[ai][bj][m][0], v1 = acc[ai][bj][m][1];
                    u32x4 w; w.x = cvt_pk_bf16(v0[0], v0[1]); w.y = cvt_pk_bf16(v0[2], v0[3]); w.z = cvt_pk_bf16(v1[0], v1[1]); w.w = cvt_pk_bf16(v1[2], v1[3]);
                    *(u32x4*)(MG + off) = w;
                }
    }
};


struct EpiFinal {
    static constexpr bool PERM = true, AFTER_DRAIN = true, HAS_MID = false;
    const bf16_t* base; float* out; float* ssq_out; const float* g; float alpha; const XcdBarrier* bar;
    __device__ __forceinline__ void fused(f32x4 (&acc)[2][2][4][2], const Unit& u, int wr, int wc, int fr, int fq, PG8_LAS unsigned char* lds, int wid, int lane) const {
        const int row0 = u.pm * BM + wr * 64 + fr, col0 = u.pn * BM + wc * 32 + 8 * fq;
#pragma unroll
        for (int ai = 0; ai < 2; ++ai)
#pragma unroll
            for (int m = 0; m < 4; ++m) {
                const int row = row0 + ai * HALF + m * 16; float ss = 0.f;
#pragma unroll
                for (int bj = 0; bj < 2; ++bj) {
                    const size_t off = (size_t)row * 1024 + col0 + bj * HALF;
                    const u32x4 w = *(const u32x4*)(base + off);
                    const f32x4 b0 = (f32x4){bf_lo(w.x), bf_hi(w.x), bf_lo(w.y), bf_hi(w.y)}, b1 = (f32x4){bf_lo(w.z), bf_hi(w.z), bf_lo(w.w), bf_hi(w.w)};
                    const f32x4 v0 = b0 + acc[ai][bj][m][0] * alpha, v1 = b1 + acc[ai][bj][m][1] * alpha;
                    acc[ai][bj][m][0] = v0; acc[ai][bj][m][1] = v1;
                    ss += ((v0[0] * v0[0] + v0[1] * v0[1]) + (v0[2] * v0[2] + v0[3] * v0[3])) + ((v1[0] * v1[0] + v1[1] * v1[1]) + (v1[2] * v1[2] + v1[3] * v1[3]));
                }
                ss += __shfl_xor(ss, 16); ss += __shfl_xor(ss, 32);
                if (fq == 0) ssq_out[(size_t)row * 16 + u.pn * 4 + wc] = ss;
                if (m & 1) asm volatile("" ::: "memory");
            }
        xcd_barrier(*bar);
        f32x4 gv[2][2];
#pragma unroll
        for (int bj = 0; bj < 2; ++bj) { gv[bj][0] = *(const f32x4*)(g + col0 + bj * HALF); gv[bj][1] = *(const f32x4*)(g + col0 + bj * HALF + 4); }
#pragma unroll
        for (int ai = 0; ai < 2; ++ai)
#pragma unroll
            for (int m = 0; m < 4; ++m) {
                const int row = row0 + ai * HALF + m * 16; const float rs = row_rstd(ssq_out, row);
#pragma unroll
                for (int bj = 0; bj < 2; ++bj) {
                    const size_t off = (size_t)row * 1024 + col0 + bj * HALF;
                    *(f32x4*)(out + off) = acc[ai][bj][m][0] * rs * gv[bj][0]; *(f32x4*)(out + off + 4) = acc[ai][bj][m][1] * rs * gv[bj][1];
                }
            }
    }
};
template <class Epi, class Sched, bool ALIGN_EPI = false, bool SP2 = false>
__device__ __forceinline__ void gemm_phase(PG8_LAS unsigned char* lds, const Gemm g, const Sched& S, const Epi& E) {
    const int tid = threadIdx.x, wid = __builtin_amdgcn_readfirstlane(tid >> 6), lane = tid & 63, wr = wid >> 2, wc = wid & 3, fr = lane & 15, fq = lane >> 4;
    const int K = g.K, nt = K / BK;
    unsigned voffA[2], voffB[2];
#pragma unroll
    for (int i = 0; i < 2; ++i) { int R, C; stage_rc(tid * 16 + i * 8192, R, C); const int Rb = Epi::PERM ? ((R & ~31) + perm32(R & 31)) : R;
        voffA[i] = (unsigned)(R * K + C) * 2u; voffB[i] = (unsigned)(Rb * K + C) * 2u; }
    const size_t kstep = (size_t)(BK * 2);
    const size_t hstep = (size_t)HALF * K * 2;
    const size_t tstep = 2 * hstep;
    const unsigned ldsw = (unsigned)wid * 1024u;
    const int aoff = lds_byte(wr * 64 + fr, fq * 8), boff = lds_byte(wc * 32 + fr, fq * 8);
#define PG8_SA(b, h) (((b) * 2 + (h)) * HTB)
#define PG8_SB(b, h) ((4 + (b) * 2 + (h)) * HTB)
#define PG8_STAGE(bufoff, gbase, voff) do { _Pragma("unroll") for (int _i = 0; _i < 2; ++_i) \
        __builtin_amdgcn_global_load_lds((const unsigned*)((const char*)(gbase) + (voff)[_i]), (PG8_LAS unsigned*)(lds + (bufoff) + ldsw + _i * 8192), 16, 0, 0); } while (0)
#define PG8_LDA(dst, b, h) do { _Pragma("unroll") for (int m = 0; m < 4; ++m) _Pragma("unroll") for (int k = 0; k < 2; ++k) dst[m][k] = *(const PG8_LAS bf16x8*)(lds + PG8_SA(b, h) + aoff + m * 2048 + k * 1024); } while (0)
#define PG8_LDB(dst, b, h) do { _Pragma("unroll") for (int n = 0; n < 2; ++n) _Pragma("unroll") for (int k = 0; k < 2; ++k) dst[n][k] = *(const PG8_LAS bf16x8*)(lds + PG8_SB(b, h) + boff + n * 2048 + k * 1024); } while (0)
#define PG8_MMA(ai, bj, At, Bt) do { __builtin_amdgcn_s_setprio(1); _Pragma("unroll") for (int m = 0; m < 4; ++m) _Pragma("unroll") for (int n = 0; n < 2; ++n) _Pragma("unroll") for (int k = 0; k < 2; ++k) \
        acc[ai][bj][m][n] = __builtin_amdgcn_mfma_f32_16x16x32_bf16(Bt[n][k], At[m][k], acc[ai][bj][m][n], 0, 0, 0); __builtin_amdgcn_s_setprio(0); } while (0)
#define PG8_WAIT_V(n) asm volatile("s_waitcnt vmcnt(" #n ")" ::: "memory")
#define PG8_WAIT_L(n) asm volatile("s_waitcnt lgkmcnt(" #n ")" ::: "memory")
#define PG8_BAR __builtin_amdgcn_s_barrier()
#define PG8_SCHED __builtin_amdgcn_sched_barrier(0)
    Unit cur, nxt; int ui = 0;
    if (!S.next(0, cur)) return;
    f32x4 acc[2][2][4][2];
#pragma unroll
    for (int a = 0; a < 2; ++a)
#pragma unroll
        for (int b = 0; b < 2; ++b)
#pragma unroll
            for (int m = 0; m < 4; ++m)
#pragma unroll
                for (int n = 0; n < 2; ++n) acc[a][b][m][n] = (f32x4){0.f, 0.f, 0.f, 0.f};
    bf16x8 At[4][2], B0[2][2], B1[2][2];
    const char* cA = (const char*)g.A + (size_t)cur.pm * tstep; const char* cB = (const char*)g.Bt + (size_t)cur.pn * tstep;
    S.a_ready(cur);
    if constexpr (SP2) {
        PG8_STAGE(PG8_SB(0, 0), cB, voffB); PG8_STAGE(PG8_SB(0, 1), cB + hstep, voffB); PG8_STAGE(PG8_SA(0, 0), cA, voffA); PG8_STAGE(PG8_SA(0, 1), cA + hstep, voffA);
        if (wr == 1) PG8_BAR;
        PG8_WAIT_V(2); PG8_BAR;
        PG8_STAGE(PG8_SB(1, 0), cB + kstep, voffB); PG8_STAGE(PG8_SA(1, 0), cA + kstep, voffA); PG8_STAGE(PG8_SB(1, 1), cB + hstep + kstep, voffB);
        PG8_WAIT_V(6); PG8_BAR;
    } else {
        PG8_STAGE(PG8_SB(0, 0), cB, voffB); PG8_STAGE(PG8_SA(0, 0), cA, voffA); PG8_STAGE(PG8_SB(0, 1), cB + hstep, voffB); PG8_STAGE(PG8_SA(0, 1), cA + hstep, voffA);
        if (wr == 1) PG8_BAR;
        PG8_WAIT_V(4); PG8_BAR;
        PG8_STAGE(PG8_SB(1, 0), cB + kstep, voffB); PG8_STAGE(PG8_SA(1, 0), cA + kstep, voffA); PG8_STAGE(PG8_SB(1, 1), cB + hstep + kstep, voffB);
        PG8_WAIT_V(6); PG8_BAR;
    }
    for (;;) {
        const bool has_next = S.next(ui + 1, nxt);
        const char* nA = has_next ? (const char*)g.A + (size_t)nxt.pm * tstep : cA; const char* nB = has_next ? (const char*)g.Bt + (size_t)nxt.pn * tstep : cB;
        for (int t = 0; t < nt; t += 2) {
            if constexpr (Epi::HAS_MID) { if (t == (nt >> 1)) E.mid(acc, cur, wr, wc, fr, fq); }
            const bool last = (t == nt - 2);
            const char* a1 = cA + (size_t)(t + 1) * kstep;
            const char* a2 = last ? nA : cA + (size_t)(t + 2) * kstep; const char* b2 = last ? nB : cB + (size_t)(t + 2) * kstep;
            const char* a3 = a2 + kstep; const char* b3 = b2 + kstep;
            if (last && has_next) S.a_ready(nxt);
            if constexpr (SP2) {
            PG8_LDB(B0, 0, 0); PG8_LDB(B1, 0, 1); PG8_SCHED; PG8_LDA(At, 0, 0); PG8_STAGE(PG8_SA(1, 1), a1 + hstep, voffA);
            PG8_WAIT_V(8); PG8_WAIT_L(0); PG8_BAR; PG8_MMA(0, 0, At, B0); PG8_MMA(0, 1, At, B1); PG8_BAR; PG8_SCHED;
            PG8_LDA(At, 0, 1); PG8_STAGE(PG8_SB(0, 0), b2, voffB); PG8_STAGE(PG8_SB(0, 1), b2 + hstep, voffB); PG8_STAGE(PG8_SA(0, 0), a2, voffA);
            PG8_WAIT_V(8); PG8_WAIT_L(0); PG8_BAR; PG8_MMA(1, 0, At, B0); PG8_MMA(1, 1, At, B1); PG8_BAR; PG8_SCHED;
            PG8_LDB(B0, 1, 0); PG8_LDB(B1, 1, 1); PG8_SCHED; PG8_LDA(At, 1, 0); PG8_STAGE(PG8_SA(0, 1), a2 + hstep, voffA);
            PG8_WAIT_V(8); PG8_WAIT_L(0); PG8_BAR; PG8_MMA(0, 0, At, B0); PG8_MMA(0, 1, At, B1); PG8_BAR; PG8_SCHED;
            PG8_LDA(At, 1, 1); PG8_STAGE(PG8_SB(1, 0), b3, voffB); PG8_STAGE(PG8_SB(1, 1), b3 + hstep, voffB); PG8_STAGE(PG8_SA(1, 0), a3, voffA);
            PG8_WAIT_V(8); PG8_WAIT_L(0); PG8_BAR; PG8_MMA(1, 0, At, B0); PG8_MMA(1, 1, At, B1); PG8_BAR; PG8_SCHED;
            } else {
            PG8_LDB(B0, 0, 0); PG8_SCHED; PG8_LDA(At, 0, 0); PG8_STAGE(PG8_SA(1, 1), a1 + hstep, voffA);
            PG8_WAIT_L(8); PG8_BAR; PG8_WAIT_L(0); PG8_MMA(0, 0, At, B0); PG8_BAR; PG8_SCHED;
            PG8_LDB(B1, 0, 1); PG8_STAGE(PG8_SB(0, 0), b2, voffB);
            PG8_BAR; PG8_WAIT_L(0); PG8_MMA(0, 1, At, B1); PG8_BAR;
            PG8_LDA(At, 0, 1); PG8_STAGE(PG8_SA(0, 0), a2, voffA);
            PG8_BAR; PG8_WAIT_L(0); PG8_MMA(1, 0, At, B0); PG8_BAR; PG8_SCHED;
            PG8_STAGE(PG8_SB(0, 1), b2 + hstep, voffB);
            PG8_WAIT_V(6); PG8_BAR; PG8_MMA(1, 1, At, B1); PG8_BAR;
            PG8_LDB(B0, 1, 0); PG8_SCHED; PG8_LDA(At, 1, 0); PG8_STAGE(PG8_SA(0, 1), a2 + hstep, voffA);
            PG8_WAIT_L(8); PG8_BAR; PG8_WAIT_L(0); PG8_MMA(0, 0, At, B0); PG8_BAR; PG8_SCHED;
            PG8_LDB(B1, 1, 1); PG8_STAGE(PG8_SB(1, 0), b3, voffB);
            PG8_BAR; PG8_WAIT_L(0); PG8_MMA(0, 1, At, B1); PG8_BAR;
            PG8_LDA(At, 1, 1); PG8_STAGE(PG8_SA(1, 0), a3, voffA);
            PG8_BAR; PG8_WAIT_L(0); PG8_MMA(1, 0, At, B0); PG8_BAR; PG8_SCHED;
            PG8_STAGE(PG8_SB(1, 1), b3 + hstep, voffB);
            PG8_WAIT_V(6); PG8_BAR; PG8_MMA(1, 1, At, B1); PG8_BAR;
            }
        }
        if constexpr (ALIGN_EPI) { if (wr == 0) PG8_BAR; }
        if constexpr (!Epi::AFTER_DRAIN) { E(acc, cur, wr, wc, fr, fq); S.done(cur); }
        if (!has_next) break;
#pragma unroll
        for (int a = 0; a < 2; ++a)
#pragma unroll
            for (int b = 0; b < 2; ++b)
#pragma unroll
                for (int m = 0; m < 4; ++m)
#pragma unroll
                    for (int n = 0; n < 2; ++n) acc[a][b][m][n] = (f32x4){0.f, 0.f, 0.f, 0.f};
        cur = nxt; cA = nA; cB = nB; ++ui;
        if constexpr (ALIGN_EPI) { if (wr == 1) PG8_BAR; }
    }
    PG8_WAIT_V(0);
    if constexpr (!ALIGN_EPI) { if (wr == 0) PG8_BAR; }
    PG8_BAR;
    if constexpr (Epi::AFTER_DRAIN) { E.fused(acc, cur, wr, wc, fr, fq, lds, wid, lane); S.done(cur); }
#undef PG8_SA
#undef PG8_SB
#undef PG8_STAGE
#undef PG8_LDA
#undef PG8_LDB
#undef PG8_MMA
#undef PG8_WAIT_V
#undef PG8_WAIT_L
#undef PG8_BAR
#undef PG8_SCHED
}
}

constexpr int NWAVES = 8;
constexpr int NB = 4, SEQ = 4096, D = 1024, M = NB * SEQ, FF = 2816, DIN = 4936, NPROJ = 5120;
constexpr int C_QA = 0, C_KA = 512, C_VA = 1024, C_QB = 1536, C_KB = 2048, C_VB = 2176, C_QI = 2304, C_KI = 2816, C_WI = 2880, C_GA = 2888, C_GB = 3912;

constexpr size_t MiB = 1u << 20;
constexpr size_t WS_CTL = 0, CTL_ZERO_BYTES = 1 * MiB;
constexpr size_t WS_ROPE = 1 * MiB;
constexpr size_t WS_SSQ = 2 * MiB;
constexpr size_t WS_W1 = 6 * MiB, WS_W2 = 17 * MiB, WS_WIN = 23 * MiB, WS_WAB = 33 * MiB, WS_WO = 35 * MiB, WS_W3 = 37 * MiB, WS_W4 = 48 * MiB;
constexpr size_t WS_XB = 54 * MiB;
constexpr size_t WS_MASK = 86 * MiB;
constexpr size_t WS_R = 94 * MiB;
constexpr size_t R_QAB = 0, R_KA = 32 * MiB, R_VA = 48 * MiB, R_KB = 64 * MiB, R_VB = 68 * MiB, R_QI = 72 * MiB, R_KI = 88 * MiB, R_WI = 90 * MiB, R_RAT = 91 * MiB, R_SGB = 123 * MiB, R_END = 155 * MiB;
constexpr size_t R_MG = 32 * MiB;
constexpr size_t WS_END = 256 * MiB;
static_assert(WS_R + R_END <= WS_END && WS_W4 + (size_t)D * FF * 2 <= WS_XB && WS_W1 + (size_t)2 * FF * D * 2 <= WS_W2 && WS_W2 + (size_t)D * FF * 2 <= WS_WIN && WS_WIN + (size_t)NPROJ * D * 2 <= WS_WAB, "d_ws map");
static_assert(WS_W3 + (size_t)2 * FF * D * 2 <= WS_W4 && (size_t)M * FF * 2 <= R_END && WS_XB + (size_t)M * D * 2 <= WS_MASK && WS_MASK + (size_t)M * 128 * 4 <= WS_R, "d_ws map 2");
constexpr int CW_BAR = 4096;

constexpr int RING_OFF = 0, RING_BYTES = 131072;
constexpr int LDSCTL_OFF = 159744, MISC_OFF = LDSCTL_OFF + 320;
constexpr int LDS_BYTES = 163840;
static_assert(MISC_OFF + 128 <= LDS_BYTES, "LDS map");

struct Frame {
    LAS unsigned char* lds;
    volatile LAS unsigned* MISC;
    gu32* ctl;
    int tid, lane, wave, vcu, G;
};

__device__ __forceinline__ float wave_sum(float v) {
#pragma unroll
    for (int o = 1; o < 64; o <<= 1) v += __shfl_xor(v, o);
    return v;
}
__device__ __forceinline__ int rope_perm(int pos) { if (pos >= 16) return pos; const int grp = pos >> 3, i = pos & 7; return (i < 4) ? (4 * grp + i) : (8 + 4 * grp + (i - 4)); }
__device__ __forceinline__ int proj_src_col(int r) {
    const int pn = r >> 8, j = r & 255;
    if (pn < 2) return C_QA + r;
    if (pn < 4) return C_KA + (r - 512);
    if (pn < 6) return C_VA + (r - 1024);
    if (pn < 8) { const int c = r - 1536; return C_QB + (c & ~63) + rope_perm(c & 63); }
    if (pn == 8) { if (j < 128) return C_KB + (j & ~63) + rope_perm(j & 63); return C_VB + (j - 128); }
    if (pn < 11) { const int c = r - 2304; return C_QI + (c & ~63) + rope_perm(c & 63); }
    if (pn == 11) { if (j < 64) return C_KI + rope_perm(j); if (j < 72) return C_WI + (j - 64); return -1; }
    return (j < 128) ? C_GA + 128 * (pn - 12) + j : C_GB + 128 * (pn - 12) + (j - 128);
}
__device__ __forceinline__ void p0_transpose_item(const float* W, int Nsrc, int nblk, const float* g, int kind, bf16* WT, int Kdst, int koff, LAS float* scr, int item, int lane) {
    const int kb = item / nblk, nb = item % nblk, k0 = 64 * kb, n0 = 32 * nb;
    const int r = n0 + 4 * (lane & 7);
    int sc;
    if (kind == 0) sc = r; else if (kind == 1) { const int pn = r >> 8, bj = (r >> 7) & 1, j = r & 127; sc = bj * FF + 128 * pn + j; } else sc = proj_src_col(r);
#pragma unroll
    for (int i = 0; i < 8; ++i) {
        const int kk = (lane >> 3) + 8 * i;
        f32x4 v = (f32x4){0.f, 0.f, 0.f, 0.f};
        if (sc >= 0) v = __builtin_nontemporal_load((const f32x4*)(W + (size_t)(k0 + kk) * Nsrc + sc));
        if (g) v = v * g[k0 + kk];
        LAS float* d = scr + kk * 33 + 4 * (lane & 7);
        d[0] = v.x; d[1] = v.y; d[2] = v.z; d[3] = v.w;
    }
    LDS_WAIT(); asm volatile("" ::: "memory");
    const int c = lane & 7;
#pragma unroll
    for (int j = 0; j < 4; ++j) { const int n = (lane >> 3) + 8 * j; const LAS float* s = scr + (8 * c) * 33 + n;
        v4u o; o.x = pk2(s[0 * 33], s[1 * 33]); o.y = pk2(s[2 * 33], s[3 * 33]); o.z = pk2(s[4 * 33], s[5 * 33]); o.w = pk2(s[6 * 33], s[7 * 33]);
        *(GAS v4u*)(WT + (size_t)(n0 + n) * Kdst + koff + k0 + 8 * c) = o; }
    LDS_WAIT(); asm volatile("" ::: "memory");
}
__device__ __forceinline__ void x_row_to_bf16(const float* xrow, bf16* orow, float* ssqrow, int lane) {
    const GAS f32x4* xr = (const GAS f32x4*)xrow + 2 * lane;
    f32x4 v[4]; float s = 0.f;
#pragma unroll
    for (int j = 0; j < 2; ++j) { v[2 * j] = __builtin_nontemporal_load(xr + 128 * j); v[2 * j + 1] = __builtin_nontemporal_load(xr + 128 * j + 1); }
#pragma unroll
    for (int j = 0; j < 4; ++j) s += (v[j].x * v[j].x + v[j].y * v[j].y) + (v[j].z * v[j].z + v[j].w * v[j].w);
    s = wave_sum(s);
    GAS v4u* o16 = (GAS v4u*)orow + lane;
#pragma unroll
    for (int j = 0; j < 2; ++j) { v4u o; o.x = pk2(v[2 * j].x, v[2 * j].y); o.y = pk2(v[2 * j].z, v[2 * j].w); o.z = pk2(v[2 * j + 1].x, v[2 * j + 1].y); o.w = pk2(v[2 * j + 1].z, v[2 * j + 1].w); o16[64 * j] = o; }
    if (lane < 16) ssqrow[lane] = (lane == 0) ? s : 0.f;
}

struct Args { const float* in[14]; float* out; unsigned char* ws; int ph_lo, ph_hi; };

__device__ __forceinline__ void convert_weights(Frame& F, const Args& a, int set, int gw, int NGW) {
    unsigned char* ws = a.ws;
    LAS float* scr = (LAS float*)(F.lds + RING_OFF + F.wave * 16384);
    constexpr int I_1 = (D / 64) * (2 * FF / 32), I_2 = (FF / 64) * (D / 32), I_IN = (D / 64) * (NPROJ / 32), I_AB = (512 / 64) * (D / 32), I_O = (D / 64) * (D / 32);
    if (set == 0) {
        for (int it = gw; it < I_1 + I_2 + I_IN; it += NGW) {
            int r = it;
            if (r < I_1) { p0_transpose_item(a.in[2], 2 * FF, 2 * FF / 32, a.in[1], 1, (bf16*)(ws + WS_W1), D, 0, scr, r, F.lane); continue; } r -= I_1;
            if (r < I_2) { p0_transpose_item(a.in[3], D, D / 32, nullptr, 0, (bf16*)(ws + WS_W2), FF, 0, scr, r, F.lane); continue; } r -= I_2;
            p0_transpose_item(a.in[5], DIN, NPROJ / 32, a.in[4], 2, (bf16*)(ws + WS_WIN), D, 0, scr, r, F.lane);
        }
    } else if (set == 1) {
        for (int it = gw; it < 2 * I_AB + I_O + I_1; it += NGW) {
            int r = it;
            if (r < I_AB) { p0_transpose_item(a.in[7], D, D / 32, nullptr, 0, (bf16*)(ws + WS_WAB), D, 0, scr, r, F.lane); continue; } r -= I_AB;
            if (r < I_AB) { p0_transpose_item(a.in[8], D, D / 32, nullptr, 0, (bf16*)(ws + WS_WAB), D, 512, scr, r, F.lane); continue; } r -= I_AB;
            if (r < I_O) { p0_transpose_item(a.in[9], D, D / 32, nullptr, 0, (bf16*)(ws + WS_WO), D, 0, scr, r, F.lane); continue; } r -= I_O;
            p0_transpose_item(a.in[11], 2 * FF, 2 * FF / 32, a.in[10], 1, (bf16*)(ws + WS_W3), D, 0, scr, r, F.lane);
        }
    } else {
        for (int it = gw; it < I_2; it += NGW) p0_transpose_item(a.in[12], D, D / 32, nullptr, 0, (bf16*)(ws + WS_W4), FF, 0, scr, it, F.lane);
    }
}
__device__ __forceinline__ bool tail_convert(const Frame& F) { return F.G == 256; }
__device__ __forceinline__ void p0_prologue(Frame& F, const Args& a) {
    unsigned char* ws = a.ws;
    const int gw = F.vcu * NWAVES + F.wave, NGW = F.G * NWAVES;
    convert_weights(F, a, 0, gw, NGW);
    if (!tail_convert(F)) { convert_weights(F, a, 1, gw, NGW); convert_weights(F, a, 2, gw, NGW); }
    for (int m = gw; m < M; m += NGW) x_row_to_bf16(a.in[0] + (size_t)m * D, (bf16*)(ws + WS_XB) + (size_t)m * D, (float*)(ws + WS_SSQ) + (size_t)m * 16, F.lane);
    float* rope = (float*)(ws + WS_ROPE);
    for (int i = F.vcu * (NWAVES * 64) + F.tid; i < SEQ * 8; i += F.G * NWAVES * 64) {
        const int s = i >> 3, j = i & 7;
        const float inv = powf(500000.0f, -(float)(2 * j) / 16.0f), ang = (float)s * inv;
        rope[s * 16 + j] = cosf(ang); rope[s * 16 + 8 + j] = sinf(ang);
    }
}

constexpr int RSTD_OFF = RING_BYTES;
__device__ __forceinline__ int fill_rstd_table(Frame& F, const float* ssq, const pg8::StaticOrder& S) {
    pg8::Unit u; if (!S.next(0, u)) return -1;
    if (F.tid < 256) ((LAS float*)(F.lds + RSTD_OFF))[F.tid] = pg8::row_rstd(ssq, u.pm * 256 + F.tid);
    __syncthreads();
    return u.pm;
}
__device__ __forceinline__ void p9_final(Frame& F, float* out, const float* ssq, const float* g) {
    const int gw = F.vcu * NWAVES + F.wave, NGW = F.G * NWAVES;
    for (int m = gw; m < M; m += NGW) {
        const float rs = pg8::row_rstd(ssq, m);
        GAS f32x4* xr = (GAS f32x4*)(out + (size_t)m * D) + F.lane; const f32x4* gr = (const f32x4*)g + F.lane;
#pragma unroll
        for (int j = 0; j < 4; ++j) { const f32x4 v = xr[64 * j], gg = gr[64 * j]; xr[64 * j] = v * rs * gg; }
    }
}


namespace mx {
typedef float f32x16 __attribute__((ext_vector_type(16)));
typedef short v4i16_t __attribute__((ext_vector_type(4)));
typedef __attribute__((address_space(3))) unsigned char* lptr;
typedef __attribute__((address_space(3))) const unsigned char* lcptr;
constexpr float LOG2E = 1.4426950408889634f;
constexpr float THR = 8.0f;
__device__ __forceinline__ int crow(int r, int hi) { return (r & 3) + 8 * (r >> 2) + 4 * hi; }
typedef float cv_f32x2_t __attribute__((ext_vector_type(2))); typedef __bf16 cv_bf16x2_t __attribute__((ext_vector_type(2)));
__device__ __forceinline__ unsigned cvtpk(float lo, float hi) { const cv_f32x2_t v = {lo, hi}; const cv_bf16x2_t b = __builtin_convertvector(v, cv_bf16x2_t); return __builtin_bit_cast(unsigned, b); }
__device__ __forceinline__ bf16x8 pack8(const f32x16& p, int b) {
    v4u w; w.x = cvtpk(p[b + 0], p[b + 1]); w.y = cvtpk(p[b + 2], p[b + 3]); w.z = cvtpk(p[b + 4], p[b + 5]); w.w = cvtpk(p[b + 6], p[b + 7]);
    return __builtin_bit_cast(bf16x8, w);
}
__device__ __forceinline__ bf16x8 vfrag(lcptr p) {
    const v4i16_t lo = __builtin_amdgcn_ds_read_tr16_b64_v4i16((__attribute__((address_space(3))) v4i16_t*)p);
    const v4i16_t hi = __builtin_amdgcn_ds_read_tr16_b64_v4i16((__attribute__((address_space(3))) v4i16_t*)(p + 512));
    return (bf16x8){lo[0], lo[1], lo[2], lo[3], hi[0], hi[1], hi[2], hi[3]};
}
__device__ __forceinline__ void glds16(const void* gsrc, lptr ldst) {
    unsigned keep; const unsigned dst = (unsigned)__builtin_amdgcn_readfirstlane((int)(unsigned)(size_t)ldst);
    asm volatile("s_mov_b32 %0, m0\n\ts_mov_b32 m0, %2\n\ts_nop 0\n\tglobal_load_lds_dwordx4 %1, off\n\ts_mov_b32 m0, %0" : "=&s"(keep) : "v"(gsrc), "s"(dst) : "memory");
}
#define GLDS_WAIT() asm volatile("s_waitcnt vmcnt(0)" ::: "memory")
__device__ __forceinline__ float max3f(float a, float b, float c) { float r; asm("v_max3_f32 %0, %1, %2, %3" : "=v"(r) : "v"(a), "v"(b), "v"(c)); return r; }
__device__ __forceinline__ float max2f(float a, float b) { float r; asm("v_max_f32_e32 %0, %1, %2" : "=v"(r) : "v"(a), "v"(b)); return r; }
__device__ __forceinline__ float relu1(float a) { float r; asm("v_max_f32_e32 %0, 0, %1" : "=v"(r) : "v"(a)); return r; }
struct AttnState { float m, l; f32x16 o0, o1; bool first; };

typedef __bf16 bf16x2_t __attribute__((ext_vector_type(2)));
__device__ __forceinline__ float dot2_ones(unsigned w, float acc) { return __builtin_amdgcn_fdot2_f32_bf16(__builtin_bit_cast(bf16x2_t, w), __builtin_bit_cast(bf16x2_t, 0x3F803F80u), acc, false); }
struct PK { v4u w0, w1, w2, w3; };
template <int MODE>
__device__ __forceinline__ void attn_qk(AttnState& st, lcptr Kb, const bf16x8 (&qr)[4], __attribute__((address_space(3))) float* wsf,
                                        const __attribute__((address_space(3))) float* biasl, int delta, lcptr pmask, int lane, PK& pk) {
    const int r32 = lane & 31, hi = lane >> 5;
    f32x16 p0, p1;
    bool far = false; float cinit = st.first ? 0.f : -st.m;
    if (MODE == 1) { far = (delta - 63 >= 128); if (far) cinit += biasl[256]; }
#pragma unroll
    for (int r = 0; r < 16; ++r) { p0[r] = cinit; p1[r] = cinit; }
    lcptr kp = Kb + hi * 1024 + r32 * 16;
    asm volatile("" : "+v"(kp));
    __builtin_amdgcn_s_setprio(1);
#pragma unroll
    for (int d0 = 0; d0 < 4; ++d0) {
        const bf16x8 a0 = *(const __attribute__((address_space(3))) bf16x8*)(kp + d0 * 2048);
        const bf16x8 a1 = *(const __attribute__((address_space(3))) bf16x8*)(kp + d0 * 2048 + 512);
        p0 = __builtin_amdgcn_mfma_f32_32x32x16_bf16(a0, qr[d0], p0, 0, 0, 0);
        p1 = __builtin_amdgcn_mfma_f32_32x32x16_bf16(a1, qr[d0], p1, 0, 0, 0);
    }
    __builtin_amdgcn_s_setprio(0);
    asm volatile("s_nop 15\n\ts_nop 7" : "+v"(p0), "+v"(p1) :: "memory");
    if (MODE == 1) {
        if (!far) {
            int base = delta + r32 - 4 * hi;
            asm volatile("" : "+v"(base));
#pragma unroll
            for (int r = 0; r < 16; ++r) {
                int d0i = base - ((r & 3) + 8 * (r >> 2)), d1i = d0i - 32;
                d0i = d0i < -128 ? -128 : (d0i > 128 ? 128 : d0i); d1i = d1i < -128 ? -128 : (d1i > 128 ? 128 : d1i);
                p0[r] += biasl[d0i + 128]; p1[r] += biasl[d1i + 128];
                if ((r & 3) == 3) asm volatile("" ::: "memory");
            }
        }
    }
    float ra = max3f(p0[0], p0[1], p1[0]), rb = max3f(p0[2], p0[3], p1[1]);
    ra = max3f(ra, p1[2], p1[3]);
#pragma unroll
    for (int r = 4; r < 16; r += 4) { ra = max3f(ra, p0[r], p0[r + 1]); rb = max3f(rb, p0[r + 2], p0[r + 3]); ra = max3f(ra, p1[r], p1[r + 1]); rb = max3f(rb, p1[r + 2], p1[r + 3]); }
    float rm = max2f(ra, rb);
    { const auto rr = __builtin_amdgcn_permlane32_swap(__float_as_uint(rm), __float_as_uint(rm), false, false); rm = __builtin_fmaxf(__uint_as_float(rr[0]), __uint_as_float(rr[1])); }
    if (st.first || __any(rm > THR)) {
        const float dl = st.first ? rm : __builtin_fmaxf(rm, 0.f);
        if (!st.first) {
            const float f = __builtin_amdgcn_exp2f(-dl);
            st.l *= f;
            if (hi == 0) wsf[r32] = f;
            asm volatile("s_waitcnt lgkmcnt(0)" ::: "memory");
#pragma unroll
            for (int r = 0; r < 16; ++r) { const float fr_ = wsf[crow(r, hi)]; st.o0[r] *= fr_; st.o1[r] *= fr_; }
        }
        st.m = st.first ? dl : st.m + dl; st.first = false;
#pragma unroll
        for (int r = 0; r < 16; ++r) { p0[r] -= dl; p1[r] -= dl; }
    }
#pragma unroll
    for (int r = 0; r < 16; ++r) { p0[r] = __builtin_amdgcn_exp2f(p0[r]); p1[r] = __builtin_amdgcn_exp2f(p1[r]); }
    v4u w0, w1, w2, w3;
    w0.x = cvtpk(p0[0], p0[1]); w0.y = cvtpk(p0[2], p0[3]); w0.z = cvtpk(p0[4], p0[5]); w0.w = cvtpk(p0[6], p0[7]);
    w1.x = cvtpk(p0[8], p0[9]); w1.y = cvtpk(p0[10], p0[11]); w1.z = cvtpk(p0[12], p0[13]); w1.w = cvtpk(p0[14], p0[15]);
    w2.x = cvtpk(p1[0], p1[1]); w2.y = cvtpk(p1[2], p1[3]); w2.z = cvtpk(p1[4], p1[5]); w2.w = cvtpk(p1[6], p1[7]);
    w3.x = cvtpk(p1[8], p1[9]); w3.y = cvtpk(p1[10], p1[11]); w3.z = cvtpk(p1[12], p1[13]); w3.w = cvtpk(p1[14], p1[15]);
    if (MODE == 2) {
        lcptr pm = pmask + r32 * 144 + hi * 32;
        asm volatile("" : "+v"(pm));
        const v4u m0 = *(const __attribute__((address_space(3))) v4u*)(pm), m1 = *(const __attribute__((address_space(3))) v4u*)(pm + 16);
        const v4u m2 = *(const __attribute__((address_space(3))) v4u*)(pm + 64), m3 = *(const __attribute__((address_space(3))) v4u*)(pm + 80);
        w0 &= m0; w1 &= m1; w2 &= m2; w3 &= m3;
        float sa = dot2_ones(w0.x, 0.f), sb = dot2_ones(w0.y, 0.f);
        sa = dot2_ones(w0.z, sa); sb = dot2_ones(w0.w, sb); sa = dot2_ones(w1.x, sa); sb = dot2_ones(w1.y, sb); sa = dot2_ones(w1.z, sa); sb = dot2_ones(w1.w, sb);
        sa = dot2_ones(w2.x, sa); sb = dot2_ones(w2.y, sb); sa = dot2_ones(w2.z, sa); sb = dot2_ones(w2.w, sb); sa = dot2_ones(w3.x, sa); sb = dot2_ones(w3.y, sb); sa = dot2_ones(w3.z, sa); sb = dot2_ones(w3.w, sb);
        st.l += sa + sb;
    } else {
        float sa = 0.f, sb = 0.f;
#pragma unroll
        for (int r = 0; r < 16; ++r) { sa += p0[r]; sb += p1[r]; }
        st.l += sa + sb;
    }
    pk.w0 = w0; pk.w1 = w1; pk.w2 = w2; pk.w3 = w3;
}
__device__ __forceinline__ void attn_pv(AttnState& st, lcptr Vb, const PK& pk, int lane) {
    const int hi = lane >> 5;
    const bf16x8 pa0 = __builtin_bit_cast(bf16x8, pk.w0), pa1 = __builtin_bit_cast(bf16x8, pk.w1), pa2 = __builtin_bit_cast(bf16x8, pk.w2), pa3 = __builtin_bit_cast(bf16x8, pk.w3);
    lcptr vp = Vb + ((lane >> 4) & 1) * 32 + (lane & 3) * 8 + (4 * hi + ((lane & 15) >> 2)) * 64;
    asm volatile("" : "+v"(vp));
    __builtin_amdgcn_s_setprio(1);
    st.o0 = __builtin_amdgcn_mfma_f32_32x32x16_bf16(pa0, vfrag(vp + 0 * 1024), st.o0, 0, 0, 0);
    st.o0 = __builtin_amdgcn_mfma_f32_32x32x16_bf16(pa1, vfrag(vp + 1 * 1024), st.o0, 0, 0, 0);
    st.o0 = __builtin_amdgcn_mfma_f32_32x32x16_bf16(pa2, vfrag(vp + 2 * 1024), st.o0, 0, 0, 0);
    st.o0 = __builtin_amdgcn_mfma_f32_32x32x16_bf16(pa3, vfrag(vp + 3 * 1024), st.o0, 0, 0, 0);
    asm volatile("" ::: "memory");
    st.o1 = __builtin_amdgcn_mfma_f32_32x32x16_bf16(pa0, vfrag(vp + 4096 + 0 * 1024), st.o1, 0, 0, 0);
    st.o1 = __builtin_amdgcn_mfma_f32_32x32x16_bf16(pa1, vfrag(vp + 4096 + 1 * 1024), st.o1, 0, 0, 0);
    st.o1 = __builtin_amdgcn_mfma_f32_32x32x16_bf16(pa2, vfrag(vp + 4096 + 2 * 1024), st.o1, 0, 0, 0);
    st.o1 = __builtin_amdgcn_mfma_f32_32x32x16_bf16(pa3, vfrag(vp + 4096 + 3 * 1024), st.o1, 0, 0, 0);
    __builtin_amdgcn_s_setprio(0);
}
__device__ __forceinline__ void expand_pair_masks(const __attribute__((address_space(3))) unsigned* maskl, lptr dst, int t, int tid) {
    const int q = tid >> 4, x = tid & 15, half = x >> 3, hi = (x >> 2) & 1, j = x & 3;
    const unsigned word = maskl[q * 128 + 2 * t + half];
    const unsigned nib = (word >> (8 * j + 4 * hi)) & 0xFu;
    typedef unsigned u32x2_t __attribute__((ext_vector_type(2)));
    u32x2_t o; o.x = ((nib & 1u) ? 0x0000FFFFu : 0u) | ((nib & 2u) ? 0xFFFF0000u : 0u); o.y = ((nib & 4u) ? 0x0000FFFFu : 0u) | ((nib & 8u) ? 0xFFFF0000u : 0u);
    *(__attribute__((address_space(3))) u32x2_t*)(dst + q * 144 + half * 64 + hi * 32 + j * 8) = o;
}
__device__ __forceinline__ void attn_finish(AttnState& st, __attribute__((address_space(3))) float* wsf, lptr stg, bf16* dst, int lane) {
    const int r32 = lane & 31, hi = lane >> 5;
    float l = st.l; l += __shfl_xor(l, 32);
    asm volatile("s_waitcnt lgkmcnt(0)" ::: "memory");
    if (hi == 0) wsf[32 + r32] = l;
    asm volatile("s_waitcnt lgkmcnt(0)" ::: "memory");
    __attribute__((address_space(3))) unsigned short* s16 = (__attribute__((address_space(3))) unsigned short*)stg;
#pragma unroll
    for (int r = 0; r < 16; ++r) {
        const int orow = crow(r, hi); const float rl = __builtin_amdgcn_rcpf(wsf[32 + orow]);
        s16[orow * 64 + r32] = (unsigned short)f2bf(st.o0[r] * rl);
        s16[orow * 64 + 32 + r32] = (unsigned short)f2bf(st.o1[r] * rl);
    }
    asm volatile("s_waitcnt lgkmcnt(0)" ::: "memory");
#pragma unroll
    for (int i = 0; i < 4; ++i) { const int row = i * 8 + (lane >> 3), ch = lane & 7; const v4u v = *(const __attribute__((address_space(3))) v4u*)(stg + row * 128 + ch * 16); *(GAS v4u*)(dst + (size_t)row * 1024 + ch * 8) = v; }
}

constexpr int A_KV = 0, A_WSF = 65536, A_STG = 67584, A_BIAS = 100352;
__device__ __forceinline__ void mixer_a_unit(Frame& F, const bf16* QAB, bf16* OAB, const bf16* KA, const bf16* VA, const float* rel_bias, int b, int jb, int h) {
    int lane = F.lane; asm volatile("" : "+v"(lane));
    const int wid = F.wave, r32 = lane & 31, hi = lane >> 5;
    lptr L = F.lds;
    __attribute__((address_space(3))) float* biasl = (__attribute__((address_space(3))) float*)(L + A_BIAS);
    __attribute__((address_space(3))) float* wsf = (__attribute__((address_space(3))) float*)(L + A_WSF) + wid * 64;
    for (int i = F.tid; i < 257; i += NWAVES * 64) biasl[i] = rel_bias[h * 257 + i] * LOG2E;
    const size_t rowbase = (size_t)b * SEQ; const int qrow0 = jb * 256 + wid * 32, c = 4 * jb + (wid >> 1);
    const bf16* Qw = QAB + (rowbase + qrow0) * 1024 + h * 64; bf16* Ow = OAB + (rowbase + qrow0) * 1024 + h * 64;
    bf16x8 qr[4];
#pragma unroll
    for (int d0 = 0; d0 < 4; ++d0) qr[d0] = *(const bf16x8*)(Qw + (size_t)r32 * 1024 + d0 * 16 + hi * 8);
    const int t_lo = (4 * jb - 8) < 0 ? 0 : (4 * jb - 8), t_hi = 4 * jb + 3;
    const bf16* ksrc = KA + ((size_t)(b * 64) * 8 + h) * 4096 + wid * 512 + lane * 8;
    const bf16* vsrc = VA + ((size_t)(b * 64) * 8 + h) * 4096 + wid * 512 + lane * 8;
    const int pdst = wid * 1024;
    glds16(ksrc + (size_t)t_lo * 32768, L + A_KV + pdst); glds16(vsrc + (size_t)t_lo * 32768, L + A_KV + 8192 + pdst);
    if (t_lo < t_hi) { glds16(ksrc + (size_t)(t_lo + 1) * 32768, L + A_KV + 16384 + pdst); glds16(vsrc + (size_t)(t_lo + 1) * 32768, L + A_KV + 16384 + 8192 + pdst); asm volatile("s_waitcnt vmcnt(2)" ::: "memory"); }
    else GLDS_WAIT();
    __syncthreads();
    AttnState st; st.m = 0.f; st.l = 0.f; st.first = true;
#pragma unroll
    for (int r = 0; r < 16; ++r) { st.o0[r] = 0.f; st.o1[r] = 0.f; }
    const bool late = false; PK pk; bool have = false; int pslot = 0;
    for (int t = t_lo; t <= t_hi; ++t) {
        const int sl = ((t - t_lo) & 3) * 16384;
        if (t + 2 <= t_hi) { const int s2 = ((t + 2 - t_lo) & 3) * 16384; glds16(ksrc + (size_t)(t + 2) * 32768, L + A_KV + s2 + pdst); glds16(vsrc + (size_t)(t + 2) * 32768, L + A_KV + s2 + 8192 + pdst); }
        const bool mine = (c - 8 <= t && t <= c);
        if (!late) { if (mine) { attn_qk<1>(st, L + A_KV + sl, qr, wsf, biasl, qrow0 - 64 * t, nullptr, lane, pk); attn_pv(st, L + A_KV + sl + 8192, pk, lane); } }
        else {
            if (have) { attn_pv(st, L + A_KV + pslot + 8192, pk, lane); have = false; }
            if (mine) { attn_qk<1>(st, L + A_KV + sl, qr, wsf, biasl, qrow0 - 64 * t, nullptr, lane, pk); have = true; pslot = sl; }
        }
        if (t + 2 <= t_hi) asm volatile("s_waitcnt vmcnt(2)" ::: "memory"); else GLDS_WAIT();
        __syncthreads();
    }
    if (have) attn_pv(st, L + A_KV + pslot + 8192, pk, lane);
    attn_finish(st, wsf, L + A_STG + wid * 4096, Ow, lane);
    __syncthreads();
}

constexpr int B_SCORE = 0, B_MASK = 131072, B_HIST = 147456;
constexpr int B_KV = 0, B_WSF = 156672, B_STG = 0, B_EXP = 147456;
__device__ __forceinline__ unsigned f2u(float f) { const unsigned u = __float_as_uint(f); return (u & 0x80000000u) ? ~u : (u | 0x80000000u); }

__device__ __forceinline__ void select_row_radix(const __attribute__((address_space(3))) float* sc, int limit, __attribute__((address_space(3))) unsigned* hist, __attribute__((address_space(3))) unsigned* mrow, int lane) {
    unsigned prefix = 0u, mask = 0u, kth = 256u;
    for (int shift = 24; shift >= 0; shift -= 8) {
        hist[lane] = 0u; hist[lane + 64] = 0u; hist[lane + 128] = 0u; hist[lane + 192] = 0u;
        asm volatile("s_waitcnt lgkmcnt(0)" ::: "memory");
        for (int i = 4 * lane; i < limit; i += 256) {
            const f32x4 v = *(const __attribute__((address_space(3))) f32x4*)(sc + i);
#pragma unroll
            for (int k = 0; k < 4; ++k) { const unsigned u = f2u(v[k]); if ((u & mask) == prefix) __hip_atomic_fetch_add(&hist[(u >> shift) & 255u], 1u, __ATOMIC_RELAXED, __HIP_MEMORY_SCOPE_WORKGROUP); }
        }
        asm volatile("s_waitcnt lgkmcnt(0)" ::: "memory");
        const v4u h4 = *(const __attribute__((address_space(3))) v4u*)(hist + 4 * lane);
        const unsigned h0 = h4.x, h1 = h4.y, h2 = h4.z, h3 = h4.w;
        const unsigned sl = h0 + h1 + h2 + h3;
        unsigned v = sl;
#pragma unroll
        for (int o = 1; o < 64; o <<= 1) { const unsigned tt = __shfl_down(v, o); if (lane + o < 64) v += tt; }
        const unsigned above = v - sl;
        const bool cross = (above < kth) && (kth <= v);
        unsigned digit = 0u, knew = 0u;
        if (cross) {
            unsigned cum = above;
            if (cum + h3 >= kth) { digit = 4 * lane + 3; knew = kth - cum; }
            else { cum += h3;
                if (cum + h2 >= kth) { digit = 4 * lane + 2; knew = kth - cum; }
                else { cum += h2;
                    if (cum + h1 >= kth) { digit = 4 * lane + 1; knew = kth - cum; }
                    else { cum += h1; digit = 4 * lane; knew = kth - cum; } } }
        }
        const unsigned long long bal = __ballot(cross);
        const int src = (int)__builtin_ctzll(bal | (1ull << 63));
        digit = __shfl(digit, src); kth = __shfl(knew, src);
        prefix |= digit << shift; mask |= 0xFFu << shift;
    }
    unsigned ceq = 0u;
    for (int base = 0; base < limit; base += 256) {
        float vv[4];
#pragma unroll
        for (int k = 0; k < 4; ++k) vv[k] = (base + 64 * k < limit) ? sc[base + 64 * k + lane] : 0.f;
#pragma unroll
        for (int k = 0; k < 4; ++k) {
            if (base + 64 * k < limit) {
                const unsigned u = f2u(vv[k]);
                const bool gt = u > prefix, eq = u == prefix;
                const unsigned long long beq = __ballot(eq);
                const unsigned pre = __builtin_amdgcn_mbcnt_hi((unsigned)(beq >> 32), __builtin_amdgcn_mbcnt_lo((unsigned)beq, 0u));
                const bool sel = gt || (eq && (ceq + pre) < kth);
                const unsigned long long bs = __ballot(sel);
                if (lane == 0) { mrow[(base >> 5) + 2 * k] = (unsigned)bs; mrow[(base >> 5) + 2 * k + 1] = (unsigned)(bs >> 32); }
                ceq += (unsigned)__builtin_popcountll(beq);
            }
        }
    }
}

constexpr int SEL_CAP = 156;
#ifdef SELPROBE
__device__ __forceinline__ int selrep_n(int n) { asm volatile("" : "+s"(n)); return n; }
#define SELREP(N) for (int _rep = 0, _nrep = selrep_n(N); _rep < _nrep; ++_rep)
#define SELREP_FIRST (_rep == 0)
#ifndef SELP_A
#define SELP_A 1
#endif
#ifndef SELP_B
#define SELP_B 1
#endif
#ifndef SELP_C
#define SELP_C 1
#endif
#ifndef SELP_R
#define SELP_R 1
#endif
#ifndef SELP_D
#define SELP_D 1
#endif
#else
#define SELREP(N)
#define SELREP_FIRST true
#endif
__device__ __forceinline__ void select_row(const __attribute__((address_space(3))) float* sc, int limit, __attribute__((address_space(3))) unsigned* scr, __attribute__((address_space(3))) unsigned* mrow, int lane) {
    typedef unsigned u32x2_t __attribute__((ext_vector_type(2)));
    asm volatile("" : "+v"(lane));
    __attribute__((address_space(3))) u32x2_t* list = (__attribute__((address_space(3))) u32x2_t*)(scr + 64);
    float lo = INFINITY, hi = -INFINITY;
    SELREP(SELP_A) {
#pragma unroll 2
    for (int i = 4 * lane; i < limit; i += 256) {
        const f32x4 v = *(const __attribute__((address_space(3))) f32x4*)(sc + i);
        lo = fminf(lo, fminf(fminf(v[0], v[1]), fminf(v[2], v[3]))); hi = fmaxf(hi, fmaxf(fmaxf(v[0], v[1]), fmaxf(v[2], v[3])));
    }
#pragma unroll
    for (int o = 1; o < 64; o <<= 1) { lo = fminf(lo, __shfl_xor(lo, o)); hi = fmaxf(hi, __shfl_xor(hi, o)); }
    }
    if (!(hi > lo)) { select_row_radix(sc, limit, scr, mrow, lane); return; }
    const float scale = 255.99f / (hi - lo);
    scr[lane] = 0u; scr[lane + 64] = 0u; scr[lane + 128] = 0u; scr[lane + 192] = 0u;
    asm volatile("s_waitcnt lgkmcnt(0)" ::: "memory");
    SELREP(SELP_B) {
    const unsigned addv = SELREP_FIRST ? 1u : 0u;
#pragma unroll 2
    for (int i = 4 * lane; i < limit; i += 256) {
        const f32x4 v = *(const __attribute__((address_space(3))) f32x4*)(sc + i);
#pragma unroll
        for (int k = 0; k < 4; ++k) { int bn = (int)((v[k] - lo) * scale); bn = bn > 255 ? 255 : bn; __hip_atomic_fetch_add(&scr[bn], addv, __ATOMIC_RELAXED, __HIP_MEMORY_SCOPE_WORKGROUP); }
    }
    }
    asm volatile("s_waitcnt lgkmcnt(0)" ::: "memory");
    int b1; unsigned kth, c1;
    {
        const v4u h4 = *(const __attribute__((address_space(3))) v4u*)(scr + 4 * lane);
        const unsigned h0 = h4.x, h1 = h4.y, h2 = h4.z, h3 = h4.w, sl = h0 + h1 + h2 + h3;
        unsigned v = sl;
#pragma unroll
        for (int o = 1; o < 64; o <<= 1) { const unsigned tt = __shfl_down(v, o); if (lane + o < 64) v += tt; }
        const unsigned above = v - sl;
        const bool cross = (above < 256u) && (256u <= v);
        unsigned digit = 0u, knew = 0u, cbin = 0u;
        if (cross) {
            unsigned cum = above;
            if (cum + h3 >= 256u) { digit = 4 * lane + 3; knew = 256u - cum; cbin = h3; }
            else { cum += h3;
                if (cum + h2 >= 256u) { digit = 4 * lane + 2; knew = 256u - cum; cbin = h2; }
                else { cum += h2;
                    if (cum + h1 >= 256u) { digit = 4 * lane + 1; knew = 256u - cum; cbin = h1; }
                    else { cum += h1; digit = 4 * lane; knew = 256u - cum; cbin = h0; } } }
        }
        const unsigned long long bal = __ballot(cross);
        const int src = (int)__builtin_ctzll(bal | (1ull << 63));
        b1 = (int)__shfl(digit, src); kth = __shfl(knew, src); c1 = __shfl(cbin, src);
    }
    if (c1 > (unsigned)SEL_CAP) { select_row_radix(sc, limit, scr, mrow, lane); return; }
    b1 = __builtin_amdgcn_readfirstlane(b1); kth = (unsigned)__builtin_amdgcn_readfirstlane((int)kth); c1 = (unsigned)__builtin_amdgcn_readfirstlane((int)c1);
    asm volatile("s_waitcnt lgkmcnt(0)" ::: "memory");
    unsigned cnt = 0u;
#define MXB_SEL_GROUP(VAL, KEY0, W) do { int bn_ = (int)(((VAL) - lo) * scale); bn_ = bn_ > 255 ? 255 : bn_; \
        const unsigned long long gt_ = __ballot(bn_ > b1); const unsigned gl_ = (unsigned)gt_, gh_ = (unsigned)(gt_ >> 32); \
        asm volatile("s_nop 1\n\tv_writelane_b32 %0, %1, " #W "\n\tv_writelane_b32 %0, %2, " #W "+1" : "+v"(mw) : "s"(gl_), "s"(gh_));     \
        const bool mt_ = (bn_ == b1); const unsigned long long bm_ = __ballot(mt_); \
        if (bm_) { if (mt_) { const unsigned pos_ = cnt + __builtin_amdgcn_mbcnt_hi((unsigned)(bm_ >> 32), __builtin_amdgcn_mbcnt_lo((unsigned)bm_, 0u)); list[pos_] = (u32x2_t){~(unsigned)((KEY0) + lane), f2u(VAL)}; } \
            cnt += (unsigned)__builtin_popcountll(bm_); } } while (0)
    {
        unsigned mw = 0u;
        int base = 0;
#pragma unroll 1
        for (; base + 512 <= limit; base += 512) {
            float v[8];
#pragma unroll
            for (int g = 0; g < 8; ++g) v[g] = sc[base + 64 * g + lane];
            MXB_SEL_GROUP(v[0], base, 0); MXB_SEL_GROUP(v[1], base + 64, 2); MXB_SEL_GROUP(v[2], base + 128, 4); MXB_SEL_GROUP(v[3], base + 192, 6);
            MXB_SEL_GROUP(v[4], base + 256, 8); MXB_SEL_GROUP(v[5], base + 320, 10); MXB_SEL_GROUP(v[6], base + 384, 12); MXB_SEL_GROUP(v[7], base + 448, 14);
            if (lane < 16) mrow[(base >> 5) + lane] = mw;
        }
#pragma unroll 1
        for (; base < limit; base += 64) { const float v1 = sc[base + lane]; MXB_SEL_GROUP(v1, base, 0); if (lane < 2) mrow[(base >> 5) + lane] = mw; }
    }
#undef MXB_SEL_GROUP
    if (lane < 4) list[c1 + lane] = (u32x2_t){0u, 0u};
    asm volatile("s_waitcnt lgkmcnt(0)" ::: "memory");
#pragma unroll 1
    for (int c0 = 0; c0 < SEL_CAP; c0 += 64) {
        if ((unsigned)c0 >= c1) break;
        const bool vc = (unsigned)(c0 + lane) < c1;
        u32x2_t e = (u32x2_t){0xFFFFFFFFu, 0xFFFFFFFFu};
        if (vc) e = list[c0 + lane];
        const unsigned long long me = ((unsigned long long)e.y << 32) | e.x;
        unsigned rk = 0u;
        for (unsigned j = 0; j < c1; j += 4) {
            const v4u o0 = *(const __attribute__((address_space(3))) v4u*)(list + j), o1 = *(const __attribute__((address_space(3))) v4u*)(list + j + 2);
            rk += ((((unsigned long long)o0.y << 32) | o0.x) > me) ? 1u : 0u; rk += ((((unsigned long long)o0.w << 32) | o0.z) > me) ? 1u : 0u;
            rk += ((((unsigned long long)o1.y << 32) | o1.x) > me) ? 1u : 0u; rk += ((((unsigned long long)o1.w << 32) | o1.z) > me) ? 1u : 0u;
        }
        if (vc && rk < kth) { const unsigned idx = ~e.x; __hip_atomic_fetch_or(&mrow[idx >> 5], 1u << (idx & 31u), __ATOMIC_RELAXED, __HIP_MEMORY_SCOPE_WORKGROUP); }
    }
}

__device__ __forceinline__ void mixer_b_unit(Frame& F, const bf16* QAB, bf16* OAB, const bf16* KB, const bf16* VB, const bf16* QI, const bf16* KI, const float* WI, int b, int qt) {
    int lane = F.lane; asm volatile("" : "+v"(lane));
    const int wid = F.wave; int r32 = lane & 31, hi = lane >> 5;
    lptr L = F.lds;
    const size_t rowbase = (size_t)b * SEQ; const int q0 = qt * 32, limit = ((q0 >> 6) + 1) * 64;
    __attribute__((address_space(3))) unsigned* maskl = (__attribute__((address_space(3))) unsigned*)(L + B_MASK);
    if (limit <= 256) {
        for (int i = F.tid; i < 32 * 128; i += NWAVES * 64) maskl[i] = ((i & 127) < (limit >> 5)) ? 0xFFFFFFFFu : 0u;
        __syncthreads();
    } else {
        __attribute__((address_space(3))) float* score = (__attribute__((address_space(3))) float*)(L + B_SCORE);
        bf16x8 qa[2][4], qan[2][4]; f32x4 wv[2][4], wvn[2][4];
#define MXB_LOAD_Q(QA, WV, QS0) do { _Pragma("unroll") for (int rt = 0; rt < 2; ++rt) { const size_t qrow = rowbase + (QS0) + 4 * rt + (r32 >> 3); \
            _Pragma("unroll") for (int ks = 0; ks < 4; ++ks) QA[rt][ks] = *(const bf16x8*)(QI + qrow * 512 + (r32 & 7) * 64 + ks * 16 + hi * 8); \
            _Pragma("unroll") for (int qq = 0; qq < 4; ++qq) WV[rt][qq] = *(const f32x4*)(WI + (rowbase + (QS0) + 4 * rt + qq) * 8 + 4 * hi); } } while (0)
        MXB_LOAD_Q(qa, wv, q0);
        bf16x8 kb0[4];
        { const bf16* kp_ = KI + ((size_t)(b * 128 + wid) * 8 + hi) * 256 + r32 * 8;
#pragma unroll
          for (int ks = 0; ks < 4; ++ks) kb0[ks] = *(const bf16x8*)(kp_ + ks * 512); }
        for (int sub = 0; sub < 4; ++sub) {
            float wreg[2][16];
#pragma unroll
            for (int rt = 0; rt < 2; ++rt)
#pragma unroll
                for (int r = 0; r < 16; ++r) wreg[rt][r] = wv[rt][r >> 2][r & 3];
            {
            const int nkt = limit >> 5;
            bf16x8 kb[4], kn[4];
#pragma unroll
            for (int ks = 0; ks < 4; ++ks) kb[ks] = kb0[ks];
#define MXB_IDX_MFMA(ACC, RT, KB) do { _Pragma("unroll") for (int r_ = 0; r_ < 16; ++r_) ACC[r_] = 0.f; \
            _Pragma("unroll") for (int ks_ = 0; ks_ < 4; ++ks_) ACC = __builtin_amdgcn_mfma_f32_32x32x16_bf16(qa[RT][ks_], KB[ks_], ACC, 0, 0, 0); } while (0)
#define MXB_IDX_EPI(ACC, RT, KT) do { float part_[4]; \
            _Pragma("unroll") for (int qq_ = 0; qq_ < 4; ++qq_) { float pp_ = 0.f; \
                _Pragma("unroll") for (int i_ = 0; i_ < 4; ++i_) { const float av_ = ACC[4 * qq_ + i_]; const int xb_ = __float_as_int(av_); pp_ += wreg[RT][4 * qq_ + i_] * __int_as_float(xb_ > 0 ? xb_ : 0); } \
                part_[qq_] = pp_; } \
              \
            const auto s02_ = __builtin_amdgcn_permlane32_swap(__float_as_uint(part_[0]), __float_as_uint(part_[2]), false, false); \
            const auto s13_ = __builtin_amdgcn_permlane32_swap(__float_as_uint(part_[1]), __float_as_uint(part_[3]), false, false); \
            const float v0_ = __uint_as_float(s02_[0]) + __uint_as_float(s02_[1]), v1_ = __uint_as_float(s13_[0]) + __uint_as_float(s13_[1]); \
            score[(4 * (RT) + 2 * hi) * limit + 32 * (KT) + r32] = v0_ + 0.0f; \
            score[(4 * (RT) + 2 * hi + 1) * limit + 32 * (KT) + r32] = v1_ + 0.0f; } while (0)
            {
                f32x16 a0, a1;
                int kt = wid;
#define MXB_IDX_SCHED() do { _Pragma("unroll") for (int g_ = 0; g_ < 4; ++g_) { __builtin_amdgcn_sched_group_barrier(0x008, 1, 0); __builtin_amdgcn_sched_group_barrier(0x002, 11, 0); } \
                __builtin_amdgcn_sched_barrier(0); } while (0)
#define MXB_IDX_LOADK(KD, KT_) do { const bf16* kp_ = KI + ((size_t)(b * 128 + (KT_)) * 8 + hi) * 256 + r32 * 8; \
                _Pragma("unroll") for (int ks = 0; ks < 4; ++ks) KD[ks] = *(const bf16x8*)(kp_ + ks * 512); } while (0)
#define MXB_IDX_TRIP(K0, K1) do { \
                MXB_IDX_MFMA(a1, 1, K0); MXB_IDX_EPI(a0, 0, kt); MXB_IDX_SCHED(); \
                MXB_IDX_LOADK(K0, (kt + 2 * NWAVES < nkt) ? kt + 2 * NWAVES : wid); \
                MXB_IDX_MFMA(a0, 0, K1);   \
                MXB_IDX_EPI(a1, 1, kt); MXB_IDX_SCHED(); } while (0)
                MXB_IDX_LOADK(kn, (kt + NWAVES < nkt) ? kt + NWAVES : kt);
                MXB_IDX_MFMA(a0, 0, kb);
                for (;;) {
                    MXB_IDX_TRIP(kb, kn);
                    if (kt + NWAVES >= nkt) break;
                    kt += NWAVES;
                    MXB_IDX_TRIP(kn, kb);
                    if (kt + NWAVES >= nkt) break;
                    kt += NWAVES;
                }
            }
#undef MXB_IDX_TRIP
#undef MXB_IDX_SCHED
#undef MXB_IDX_LOADK
#undef MXB_IDX_MFMA
#undef MXB_IDX_EPI
            }
            if (sub < 3) MXB_LOAD_Q(qan, wvn, q0 + 8 * (sub + 1));
            __syncthreads();
            select_row(score + wid * limit, limit, (__attribute__((address_space(3))) unsigned*)(L + B_HIST) + wid * 384, maskl + (8 * sub + wid) * 128, lane);
            __syncthreads();
#pragma unroll
            for (int rt = 0; rt < 2; ++rt) {
#pragma unroll
                for (int ks = 0; ks < 4; ++ks) qa[rt][ks] = qan[rt][ks];
#pragma unroll
                for (int qq = 0; qq < 4; ++qq) wv[rt][qq] = wvn[rt][qq];
            }
        }
    }
    asm volatile("" : "+v"(lane)); r32 = lane & 31; hi = lane >> 5;
    const int h = wid, g = wid >> 2;
    __attribute__((address_space(3))) float* wsf = (__attribute__((address_space(3))) float*)(L + B_WSF) + wid * 64;
    const bf16* Qw = QAB + (rowbase + q0) * 1024 + 512 + h * 64; bf16* Ow = OAB + (rowbase + q0) * 1024 + 512 + h * 64;
    bf16x8 qr[4];
#pragma unroll
    for (int d0 = 0; d0 < 4; ++d0) qr[d0] = *(const bf16x8*)(Qw + (size_t)r32 * 1024 + d0 * 16 + hi * 8);
    const int nt = limit >> 6;
    const bf16* kvsrc = KB + (size_t)(b * 64) * 16384 + wid * 512 + lane * 8;
    const int pdst = wid * 1024;
    {
    glds16(kvsrc, L + B_KV + pdst); glds16(kvsrc + 4096, L + B_KV + 8192 + pdst); glds16(kvsrc + 8192, L + B_KV + 16384 + pdst); glds16(kvsrc + 12288, L + B_KV + 24576 + pdst);
    if (nt > 1) { const size_t adv = (size_t)16384; lptr nb = L + B_KV + 32768 + pdst;
        glds16(kvsrc + adv, nb); glds16(kvsrc + adv + 4096, nb + 8192); glds16(kvsrc + adv + 8192, nb + 16384); glds16(kvsrc + adv + 12288, nb + 24576); }
    expand_pair_masks(maskl, L + B_EXP, 0, F.tid);
    if (nt > 1) asm volatile("s_waitcnt vmcnt(4)" ::: "memory"); else GLDS_WAIT();
    __syncthreads();
    AttnState st; st.m = 0.f; st.l = 0.f; st.first = true;
#pragma unroll
    for (int r = 0; r < 16; ++r) { st.o0[r] = 0.f; st.o1[r] = 0.f; }
    const bool late = false; PK pk; bool have = false;
    for (int t = 0; t < nt; ++t) {
        const int cur = t & 1, sl = (t & 3) * 32768;
        if (t + 2 < nt) { const size_t adv = (size_t)(t + 2) * 16384; lptr nb = L + B_KV + ((t + 2) & 3) * 32768 + pdst;
            glds16(kvsrc + adv, nb); glds16(kvsrc + adv + 4096, nb + 8192); glds16(kvsrc + adv + 8192, nb + 16384); glds16(kvsrc + adv + 12288, nb + 24576); }
        if (t + 1 < nt) expand_pair_masks(maskl, L + B_EXP + (cur ^ 1) * 4608, t + 1, F.tid);
        if (!late) { attn_qk<2>(st, L + B_KV + sl + g * 8192, qr, wsf, nullptr, 0, L + B_EXP + cur * 4608, lane, pk); attn_pv(st, L + B_KV + sl + 16384 + g * 8192, pk, lane); }
        else {
            if (have) attn_pv(st, L + B_KV + ((t - 1) & 3) * 32768 + 16384 + g * 8192, pk, lane);
            attn_qk<2>(st, L + B_KV + sl + g * 8192, qr, wsf, nullptr, 0, L + B_EXP + cur * 4608, lane, pk); have = true;
        }
        if (t + 2 < nt) asm volatile("s_waitcnt vmcnt(4)" ::: "memory"); else GLDS_WAIT();
        __syncthreads();
    }
    if (late) attn_pv(st, L + B_KV + ((nt - 1) & 3) * 32768 + 16384 + g * 8192, pk, lane);
    __syncthreads();
    attn_finish(st, wsf, L + B_STG + wid * 4096, Ow, lane);
    __syncthreads();
    }
}

__device__ __forceinline__ void mixer_phase(Frame& F, const Args& a, unsigned char* R) {
    const bf16* QAB = (const bf16*)(R + R_QAB); bf16* OAB = (bf16*)a.out;
    for (int c = (int)blockIdx.x; c < 256; c += F.G) {
        { const int h = c & 7, b = (c >> 3) & 3, s = c >> 5;
#pragma unroll 1
          for (int i = 0; i < 2; ++i) mixer_a_unit(F, QAB, OAB, (const bf16*)(R + R_KA), (const bf16*)(R + R_VA), a.in[6], b, (i & 1) ? 15 - s : s, h); }
        { const int x = c & 7, b = x >> 1, s = ((c >> 3) << 1) | (x & 1);
#pragma unroll 1
          for (int i = 0; i < 2; ++i) mixer_b_unit(F, QAB, OAB, (const bf16*)(R + R_KB), (const bf16*)(R + R_VB), (const bf16*)(R + R_QI), (const bf16*)(R + R_KI), (const float*)(R + R_WI), b, i ? 127 - s : s); }
    }
}
}

__global__ void __launch_bounds__(NWAVES * 64, 2) mk_fwd(Args args) {
    extern __shared__ __attribute__((aligned(16))) unsigned char lds[];
    Frame F;
    F.lds = (LAS unsigned char*)lds;
    F.MISC = (volatile LAS unsigned*)(F.lds + MISC_OFF);
    F.tid = threadIdx.x; F.lane = F.tid & 63; F.wave = __builtin_amdgcn_readfirstlane(F.tid >> 6);
    F.G = gridDim.x; { const int bx = blockIdx.x; F.vcu = (F.G % 8 == 0) ? (bx % 8) * (F.G / 8) + bx / 8 : bx; }
    unsigned char* ws = args.ws;
    F.ctl = (gu32*)(ws + WS_CTL);
    for (int u = F.tid; u < (LDS_BYTES - LDSCTL_OFF) / 4; u += NWAVES * 64) ((LAS unsigned*)(F.lds + LDSCTL_OFF))[u] = 0u;
    __syncthreads();
    XcdBarrier bar = xcd_barrier_post((unsigned*)(F.ctl + CW_BAR), F.MISC + 8);
    const int lo = args.ph_lo, hi = args.ph_hi;
#define IN(k) (lo <= (k) && (k) < hi)
#define BOTH(k) (IN(k) && IN((k) + 1))
#define GRID_BAR() xcd_barrier(bar)
    bf16* XB = (bf16*)(ws + WS_XB); float* SSQ = (float*)(ws + WS_SSQ); unsigned char* R = ws + WS_R;
    constexpr size_t SSQ_STRIDE = (size_t)M * 16;

    if (IN(0)) { p0_prologue(F, args); if (BOTH(0)) GRID_BAR(); }
    if (IN(1)) {
        pg8::Gemm g{XB, (const bf16*)(ws + WS_W1), M, 2 * FF, D}; pg8::StaticOrder S; S.init(M, 2 * FF, F.G, (int)blockIdx.x);
        const int rpm = fill_rstd_table(F, SSQ, S);
        pg8::EpiSwiglu E{(bf16*)R, SSQ, (const LAS float*)(F.lds + RSTD_OFF), rpm};
        pg8::gemm_phase<pg8::EpiSwiglu, pg8::StaticOrder, true, true>(F.lds + RING_OFF, g, S, E);
        if (tail_convert(F) && (int)blockIdx.x >= 128) convert_weights(F, args, 1, ((int)blockIdx.x - 128) * NWAVES + F.wave, 128 * NWAVES);
        if (BOTH(1)) GRID_BAR();
    }
    if (IN(2)) {
        pg8::Gemm g{(const bf16*)R, (const bf16*)(ws + WS_W2), M, D, FF}; pg8::StaticOrder S; S.init(M, D, F.G, (int)blockIdx.x);
        pg8::EpiResid E{nullptr, XB, XB, SSQ + SSQ_STRIDE, 0.5f};
        pg8::gemm_phase<pg8::EpiResid, pg8::StaticOrder, true, true>(F.lds + RING_OFF, g, S, E);
        if (BOTH(2)) GRID_BAR();
    }
    if (IN(3)) {
        pg8::Gemm g{XB, (const bf16*)(ws + WS_WIN), M, NPROJ, D}; pg8::StaticOrder S; S.init(M, NPROJ, F.G, (int)blockIdx.x);
        pg8::ProjOut po{(bf16*)(R + R_QAB), (bf16*)(R + R_KA), (bf16*)(R + R_VA), (bf16*)(R + R_KB), (bf16*)(R + R_VB), (bf16*)(R + R_QI), (bf16*)(R + R_KI), (float*)(R + R_WI), (bf16*)(R + R_RAT), (bf16*)(R + R_SGB), (const float*)(ws + WS_ROPE)};
        const int rpm = fill_rstd_table(F, SSQ + SSQ_STRIDE, S);
        pg8::EpiProj E{po, SSQ + SSQ_STRIDE, (const LAS float*)(F.lds + RSTD_OFF), rpm};
        pg8::gemm_phase<pg8::EpiProj, pg8::StaticOrder, true, true>(F.lds + RING_OFF, g, S, E);
        if (BOTH(3)) GRID_BAR();
    }
    if (IN(4)) {
        mx::mixer_phase(F, args, R);
        if (BOTH(4)) GRID_BAR();
    }
    if (IN(5)) {
        pg8::Gemm g{(const bf16*)args.out, (const bf16*)(ws + WS_WAB), M, D, D}; pg8::StaticOrder S; S.init(M, D, F.G, (int)blockIdx.x);
        pg8::EpiGate E{(const bf16*)(R + R_RAT), (const bf16*)(R + R_SGB), (bf16*)(R + R_MG)};
        pg8::gemm_phase<pg8::EpiGate, pg8::StaticOrder, true, true>(F.lds + RING_OFF, g, S, E);
        if (BOTH(5)) GRID_BAR();
    }
    if (IN(6)) {
        pg8::Gemm g{(const bf16*)(R + R_MG), (const bf16*)(ws + WS_WO), M, D, D}; pg8::StaticOrder S; S.init(M, D, F.G, (int)blockIdx.x);
        pg8::EpiResid E{nullptr, XB, XB, SSQ + 2 * SSQ_STRIDE, 1.0f};
        pg8::gemm_phase<pg8::EpiResid, pg8::StaticOrder, true, true>(F.lds + RING_OFF, g, S, E);
        if (BOTH(6)) GRID_BAR();
    }
    if (IN(7)) {
        pg8::Gemm g{XB, (const bf16*)(ws + WS_W3), M, 2 * FF, D}; pg8::StaticOrder S; S.init(M, 2 * FF, F.G, (int)blockIdx.x);
        const int rpm = fill_rstd_table(F, SSQ + 2 * SSQ_STRIDE, S);
        pg8::EpiSwiglu E{(bf16*)R, SSQ + 2 * SSQ_STRIDE, (const LAS float*)(F.lds + RSTD_OFF), rpm};
        pg8::gemm_phase<pg8::EpiSwiglu, pg8::StaticOrder, true, true>(F.lds + RING_OFF, g, S, E);
        if (tail_convert(F) && (int)blockIdx.x >= 128) convert_weights(F, args, 2, ((int)blockIdx.x - 128) * NWAVES + F.wave, 128 * NWAVES);
        if (BOTH(7)) GRID_BAR();
    }
    if (IN(8) && IN(9) && F.G == 256) {
        pg8::Gemm g{(const bf16*)R, (const bf16*)(ws + WS_W4), M, D, FF}; pg8::StaticOrder S; S.init(M, D, F.G, (int)blockIdx.x);
        pg8::EpiFinal E{XB, args.out, SSQ + 3 * SSQ_STRIDE, args.in[13], 0.5f, &bar};
        pg8::gemm_phase<pg8::EpiFinal, pg8::StaticOrder, false, true>(F.lds + RING_OFF, g, S, E);
    } else {
    if (IN(8)) {
        pg8::Gemm g{(const bf16*)R, (const bf16*)(ws + WS_W4), M, D, FF}; pg8::StaticOrder S; S.init(M, D, F.G, (int)blockIdx.x);
        pg8::EpiResidF E{XB, args.out, SSQ + 3 * SSQ_STRIDE, 0.5f};
        pg8::gemm_phase<pg8::EpiResidF, pg8::StaticOrder, true, true>(F.lds + RING_OFF, g, S, E);
        if (BOTH(8)) GRID_BAR();
    }
    if (IN(9)) p9_final(F, args.out, SSQ + 3 * SSQ_STRIDE, args.in[13]);
    }
#undef IN
#undef BOTH
#undef GRID_BAR
}

static int mk_grid() {
    static int grid = 0;
    if (grid == 0) {
        int dev = 0, cus = 0, per_cu = 0;
        if (hipGetDevice(&dev) != hipSuccess || hipDeviceGetAttribute(&cus, hipDeviceAttributeMultiprocessorCount, dev) != hipSuccess) { fprintf(stderr, "kernel_launch: device query failed\n"); grid = -1; return grid; }
        if (hipFuncSetAttribute((const void*)mk_fwd, hipFuncAttributeMaxDynamicSharedMemorySize, LDS_BYTES) != hipSuccess) { fprintf(stderr, "kernel_launch: hipFuncSetAttribute failed\n"); grid = -1; return grid; }
        if (hipOccupancyMaxActiveBlocksPerMultiprocessor(&per_cu, (const void*)mk_fwd, NWAVES * 64, LDS_BYTES) != hipSuccess || per_cu < 1) { fprintf(stderr, "kernel_launch: occupancy query reports %d blocks per CU\n", per_cu); per_cu = 1; }
        (void)hipGetLastError();
        grid = cus;
    }
    return grid;
}
extern "C" void kernel_launch(void* const* d_in, const int* in_sizes, int n_in, void* d_out, int out_size, void* d_ws, size_t ws_size, hipStream_t stream) {
    const int grid = mk_grid();
    if (grid < 0) return;
    unsigned char* ws = (unsigned char*)d_ws;
    Args a{};
    for (int i = 0; i < 14; ++i) a.in[i] = (const float*)d_in[i];
    a.out = (float*)d_out; a.ws = ws;
    (void)hipMemsetAsync(ws + WS_CTL, 0, CTL_ZERO_BYTES, stream);
    a.ph_lo = 0; a.ph_hi = 10;
    hipLaunchKernelGGL(mk_fwd, dim3(grid), dim3(NWAVES * 64), LDS_BYTES, stream, a);
}
```

```cpp
#include <hip/hip_runtime.h>
#include <cstdio>
#include <cstdint>
#include <cmath>
#define GAS __attribute__((address_space(1)))
#define LAS __attribute__((address_space(3)))
typedef unsigned short bf16;
typedef unsigned v4u __attribute__((ext_vector_type(4)));
typedef float f32x4 __attribute__((ext_vector_type(4)));
typedef short bf16x8 __attribute__((ext_vector_type(8)));
typedef GAS unsigned gu32;
typedef GAS unsigned long long gu64;
#define RLX_AGENT __ATOMIC_RELAXED, __HIP_MEMORY_SCOPE_AGENT
#define LDS_WAIT() asm volatile("s_waitcnt lgkmcnt(0)" ::: "memory")
#define VM_WAIT() asm volatile("s_waitcnt vmcnt(0)" ::: "memory")
__device__ __forceinline__ unsigned long long rt() { return __builtin_amdgcn_s_memrealtime(); }
__device__ __forceinline__ unsigned f2bf(float f) { unsigned u = __builtin_bit_cast(unsigned, f); return (u + 0x7fffu + ((u >> 16) & 1u)) >> 16; }
__device__ __forceinline__ unsigned pk2(float lo, float hi) { return f2bf(lo) | (f2bf(hi) << 16); }

#define XB_TMO      128
#define XB_XCNT(j)  (256  + 64 * (j))
#define XB_XSUB(j)  (1280 + 64 * (j))
#define XB_XGEN(j)  (2304 + 64 * (j))
#define XB_TOP      3328
#define XB_TOPGEN   3392
#define XCD_BAR_WORDS 3456
#define XB_SPIN_CAP (1u << 18)

__device__ __forceinline__ unsigned xb_ld(unsigned* p)              { return __hip_atomic_load(p, __ATOMIC_RELAXED, __HIP_MEMORY_SCOPE_AGENT); }
__device__ __forceinline__ unsigned xb_add(unsigned* p, unsigned v) { return __hip_atomic_fetch_add(p, v, __ATOMIC_RELAXED, __HIP_MEMORY_SCOPE_AGENT); }
__device__ __forceinline__ unsigned xb_xcc_id() { return (unsigned)__builtin_amdgcn_s_getreg((3 << 11) | 20) & 0xFu; }
#define XB_SPIN(cond, bar) do { unsigned _sp = 0; while (cond) { __builtin_amdgcn_s_sleep(1); \
    if ((++_sp & 255u) == 0u) { if (xb_ld(&(bar)[XB_TMO])) break; if (_sp > XB_SPIN_CAP) { atomicAdd(&(bar)[XB_TMO], 1u); break; } } } } while (0)

struct XcdBarrier {
    unsigned* bar; unsigned x;
    volatile LAS unsigned* st;
};

__device__ __forceinline__ XcdBarrier xcd_barrier_post(unsigned* bar, volatile LAS unsigned* st) {
    XcdBarrier b; b.bar = bar; b.x = xb_xcc_id(); b.st = st;
    if (threadIdx.x == 0) (void)xb_add(&bar[XB_XCNT(b.x)], 1u);
    return b;
}
__device__ __forceinline__ void xcd_barrier_complete(unsigned* bar, unsigned x, unsigned& nloc, unsigned& nx) {
    const unsigned G = gridDim.x * gridDim.y * gridDim.z;
    unsigned sum, cnt, mine, sp = 0u;
    for (;;) {
        sum = 0u; cnt = 0u; mine = 0u;
#pragma unroll
        for (unsigned j = 0; j < 16; ++j) { const unsigned c = xb_ld(&bar[XB_XCNT(j)]); sum += c; cnt += (c > 0u) ? 1u : 0u; mine = (j == x) ? c : mine; }
        if (sum == G) break;
        __builtin_amdgcn_s_sleep(1);
        if ((++sp & 255u) == 0u) { if (xb_ld(&bar[XB_TMO])) break; if (sp > XB_SPIN_CAP) { atomicAdd(&bar[XB_TMO], 1u); break; } }
    }
    nloc = mine > 0u ? mine : 1u; nx = cnt > 0u ? cnt : 1u;
}

__device__ __forceinline__ void xcd_barrier(const XcdBarrier& b) {
    asm volatile("s_waitcnt vmcnt(0)" ::: "memory");
    __syncthreads();
    if (threadIdx.x == 0) {
        unsigned* bar = b.bar;
        __builtin_amdgcn_s_waitcnt(0);
        unsigned nloc = b.st[0], nx = b.st[1];
        if (nloc == 0u) { xcd_barrier_complete(bar, b.x, nloc, nx); b.st[0] = nloc; b.st[1] = nx; }
        const unsigned old = xb_add(&bar[XB_XSUB(b.x)], 1u);
        const unsigned gen = old / nloc;
        if (old + 1u == (gen + 1u) * nloc) {
            __builtin_amdgcn_fence(__ATOMIC_RELEASE, "agent");
            asm volatile("s_waitcnt vmcnt(0)" ::: "memory");
            const unsigned og = xb_add(&bar[XB_TOP], 1u);
            const unsigned tg = og / nx;
            if (og + 1u == (tg + 1u) * nx) xb_add(&bar[XB_TOPGEN], 1u);
            else XB_SPIN(xb_ld(&bar[XB_TOPGEN]) == tg, bar);
            __builtin_amdgcn_fence(__ATOMIC_ACQUIRE, "agent");
            xb_add(&bar[XB_XGEN(b.x)], 1u);
            asm volatile("s_waitcnt vmcnt(0)" ::: "memory");
        } else {
            XB_SPIN(xb_ld(&bar[XB_XGEN(b.x)]) == gen, bar);
            __builtin_amdgcn_fence(__ATOMIC_ACQUIRE, "agent");
            asm volatile("s_waitcnt vmcnt(0)" ::: "memory");
        }
    }
    __syncthreads();
}
namespace pg8 {
#define PG8_LAS __attribute__((address_space(3)))
typedef unsigned short bf16_t;
typedef short bf16x8 __attribute__((ext_vector_type(8)));
typedef float f32x4 __attribute__((ext_vector_type(4)));
typedef unsigned u32x4 __attribute__((ext_vector_type(4)));
constexpr int BM = 256, BK = 64, HALF = 128, HTB = HALF * BK * 2  , STAGE_BYTES = 8 * HTB, NXCD = 8, WGM = 8;

__host__ __device__ __forceinline__ int lds_byte(int r, int c) { const int st = (r >> 4) * 2 + (c >> 5), rr = r & 15, cc = c & 31, ob = rr * 64 + cc * 2; return st * 1024 + (ob ^ (((ob >> 9) & 1) << 5)); }
__host__ __device__ __forceinline__ void stage_rc(int b, int& R, int& C) { const int st = b / 1024, sb = b % 1024, swz = sb ^ (((sb >> 9) & 1) << 5); R = (st >> 1) * 16 + swz / 64; C = (st & 1) * 32 + (swz % 64) / 2; }
__host__ __device__ __forceinline__ int perm32(int rho) { const int n = rho >> 4, i = rho & 15; return 8 * (i >> 2) + 4 * n + (i & 3); }

struct Unit { int pm, pn; };
struct Gemm { const bf16_t* A; const bf16_t* Bt; int M, N, K; };

struct StaticOrder {
    int nM, nN, nwg, G, c;
    __host__ __device__ void init(int M, int N, int G_, int c_) { nM = M / BM; nN = N / BM; nwg = nM * nN; G = G_; c = c_; }
    __host__ __device__ bool next(int i, Unit& u) const {
        const long L = (long)i * G + c; if (L >= nwg) return false;
        int wgid = (int)L; { const int q = nwg / NXCD, r = nwg % NXCD, xcd = wgid % NXCD, off = wgid / NXCD; wgid = (xcd < r ? xcd * (q + 1) : r * (q + 1) + (xcd - r) * q) + off; }
        const int nig = WGM * nN, gid = wgid / nig, fm = gid * WGM, gsz = (nM - fm) < WGM ? (nM - fm) : WGM;
        u.pm = fm + ((wgid % nig) % gsz); u.pn = (wgid % nig) / gsz; return true;
    }
    __device__ __forceinline__ void a_ready(const Unit&) const {}
    __device__ __forceinline__ void done(const Unit&) const {}
};

typedef float cv_f32x2_t __attribute__((ext_vector_type(2))); typedef __bf16 cv_bf16x2_t __attribute__((ext_vector_type(2)));
__device__ __forceinline__ unsigned cvt_pk_bf16(float lo, float hi) { const cv_f32x2_t v = {lo, hi}; const cv_bf16x2_t b = __builtin_convertvector(v, cv_bf16x2_t); return __builtin_bit_cast(unsigned, b); }
__device__ __forceinline__ float bf_lo(unsigned w) { return __uint_as_float(w << 16); }
__device__ __forceinline__ float bf_hi(unsigned w) { return __uint_as_float(w & 0xffff0000u); }
constexpr float LOG2E = 1.4426950408889634f;
__device__ __forceinline__ float fast_sigmoid(float v) { return __builtin_amdgcn_rcpf(1.0f + __builtin_amdgcn_exp2f(-v * LOG2E)); }
__device__ __forceinline__ float row_rstd(const float* ssq, int row) {
    const f32x4* p = (const f32x4*)(ssq + (size_t)row * 16);
    const f32x4 a = p[0], b = p[1], c = p[2], d = p[3];
    const float s = (((a[0] + a[1]) + (a[2] + a[3])) + ((b[0] + b[1]) + (b[2] + b[3]))) + (((c[0] + c[1]) + (c[2] + c[3])) + ((d[0] + d[1]) + (d[2] + d[3])));
    return __builtin_amdgcn_rsqf(s * (1.0f / 1024.0f) + 1e-6f);
}

struct EpiSwiglu {
    static constexpr bool PERM = true, AFTER_DRAIN = false, HAS_MID = false;
    bf16_t* H; const float* ssq; const PG8_LAS float* rl; int rl_pm;
    __device__ __forceinline__ void operator()(const f32x4 (&acc)[2][2][4][2], const Unit& u, int wr, int wc, int fr, int fq) const {
        const int row0 = u.pm * BM + wr * 64 + fr, col0 = u.pn * 128 + wc * 32 + 8 * fq;
#pragma unroll
        for (int ai = 0; ai < 2; ++ai)
#pragma unroll
            for (int m = 0; m < 4; ++m) {
                const int row = row0 + ai * HALF + m * 16; const float rs = (u.pm == rl_pm) ? rl[row - rl_pm * BM] : row_rstd(ssq, row);
                float hv[8];
#pragma unroll
                for (int n = 0; n < 2; ++n)
#pragma unroll
                    for (int i = 0; i < 4; ++i) { const float g = acc[ai][0][m][n][i] * rs, up = acc[ai][1][m][n][i] * rs; hv[4 * n + i] = g * fast_sigmoid(g) * up; }
                u32x4 w; w.x = cvt_pk_bf16(hv[0], hv[1]); w.y = cvt_pk_bf16(hv[2], hv[3]); w.z = cvt_pk_bf16(hv[4], hv[5]); w.w = cvt_pk_bf16(hv[6], hv[7]);
                *(u32x4*)(H + (size_t)row * 2816 + col0) = w;
            }
    }
};

struct EpiResid {
    static constexpr bool PERM = true, AFTER_DRAIN = false, HAS_MID = false;
    const float* basef; const bf16_t* baseb; bf16_t* xb; float* ssq_out; float alpha;
    __device__ __forceinline__ void operator()(const f32x4 (&acc)[2][2][4][2], const Unit& u, int wr, int wc, int fr, int fq) const {
        const int row0 = u.pm * BM + wr * 64 + fr, col0 = u.pn * BM + wc * 32 + 8 * fq;
#pragma unroll
        for (int ai = 0; ai < 2; ++ai)
#pragma unroll
            for (int m = 0; m < 4; ++m) {
                const int row = row0 + ai * HALF + m * 16; float ss = 0.f;
#pragma unroll
                for (int bj = 0; bj < 2; ++bj) {
                    const size_t off = (size_t)row * 1024 + col0 + bj * HALF;
                    f32x4 b0, b1;
                    if (basef) { b0 = *(const f32x4*)(basef + off); b1 = *(const f32x4*)(basef + off + 4); }
                    else { const u32x4 w = *(const u32x4*)(baseb + off); b0 = (f32x4){bf_lo(w.x), bf_hi(w.x), bf_lo(w.y), bf_hi(w.y)}; b1 = (f32x4){bf_lo(w.z), bf_hi(w.z), bf_lo(w.w), bf_hi(w.w)}; }
                    const f32x4 v0 = b0 + acc[ai][bj][m][0] * alpha, v1 = b1 + acc[ai][bj][m][1] * alpha;
                    ss += ((v0[0] * v0[0] + v0[1] * v0[1]) + (v0[2] * v0[2] + v0[3] * v0[3])) + ((v1[0] * v1[0] + v1[1] * v1[1]) + (v1[2] * v1[2] + v1[3] * v1[3]));
                    u32x4 w; w.x = cvt_pk_bf16(v0[0], v0[1]); w.y = cvt_pk_bf16(v0[2], v0[3]); w.z = cvt_pk_bf16(v1[0], v1[1]); w.w = cvt_pk_bf16(v1[2], v1[3]); *(u32x4*)(xb + off) = w;
                }
                ss += __shfl_xor(ss, 16); ss += __shfl_xor(ss, 32);
                if (fq == 0) ssq_out[(size_t)row * 16 + u.pn * 4 + wc] = ss;
            }
    }
};

struct EpiResidF {
    static constexpr bool PERM = true, AFTER_DRAIN = false, HAS_MID = false;
    const bf16_t* base; float* out; float* ssq_out; float alpha;
    __device__ __forceinline__ void operator()(const f32x4 (&acc)[2][2][4][2], const Unit& u, int wr, int wc, int fr, int fq) const {
        const int row0 = u.pm * BM + wr * 64 + fr, col0 = u.pn * BM + wc * 32 + 8 * fq;
#pragma unroll
        for (int ai = 0; ai < 2; ++ai)
#pragma unroll
            for (int m = 0; m < 4; ++m) {
                const int row = row0 + ai * HALF + m * 16; float ss = 0.f;
#pragma unroll
                for (int bj = 0; bj < 2; ++bj) {
                    const size_t off = (size_t)row * 1024 + col0 + bj * HALF;
                    const u32x4 w = *(const u32x4*)(base + off);
                    const f32x4 b0 = (f32x4){bf_lo(w.x), bf_hi(w.x), bf_lo(w.y), bf_hi(w.y)}, b1 = (f32x4){bf_lo(w.z), bf_hi(w.z), bf_lo(w.w), bf_hi(w.w)};
                    const f32x4 v0 = b0 + acc[ai][bj][m][0] * alpha, v1 = b1 + acc[ai][bj][m][1] * alpha;
                    *(f32x4*)(out + off) = v0; *(f32x4*)(out + off + 4) = v1;
                    ss += ((v0[0] * v0[0] + v0[1] * v0[1]) + (v0[2] * v0[2] + v0[3] * v0[3])) + ((v1[0] * v1[0] + v1[1] * v1[1]) + (v1[2] * v1[2] + v1[3] * v1[3]));
                }
                ss += __shfl_xor(ss, 16); ss += __shfl_xor(ss, 32);
                if (fq == 0) ssq_out[(size_t)row * 16 + u.pn * 4 + wc] = ss;
            }
    }
};

struct ProjOut { bf16_t* QAB; bf16_t* KA; bf16_t* VA; bf16_t* KB; bf16_t* VB; bf16_t* QI; bf16_t* KI; float* WI; bf16_t* RAT; bf16_t* SGB; const float* rope; };
constexpr float QSCALE = 0.125f * LOG2E;
constexpr float WSCALE = 0.35355339059327373f * 0.125f;
struct EpiProj {
    static constexpr bool PERM = true, AFTER_DRAIN = false, HAS_MID = false;
    ProjOut o; const float* ssq; const PG8_LAS float* rl; int rl_pm;
    __device__ __forceinline__ void operator()(const f32x4 (&acc)[2][2][4][2], const Unit& u, int wr, int wc, int fr, int fq) const {
        const int row0 = u.pm * BM + wr * 64 + fr; const int pn = u.pn;
        if (pn >= 12) {
            const int col = 128 * (pn - 12) + wc * 32 + 8 * fq;
#pragma unroll
            for (int ai = 0; ai < 2; ++ai)
#pragma unroll
                for (int m = 0; m < 4; ++m) {
                    const int row = row0 + ai * HALF + m * 16; const float rs = (u.pm == rl_pm) ? rl[row - rl_pm * BM] : row_rstd(ssq, row);
                    float rt[8], sb[8];
#pragma unroll
                    for (int n = 0; n < 2; ++n)
#pragma unroll
                        for (int i = 0; i < 4; ++i) {
                            const float ea = __builtin_amdgcn_exp2f(-acc[ai][0][m][n][i] * rs * LOG2E), eb = fminf(__builtin_amdgcn_exp2f(-acc[ai][1][m][n][i] * rs * LOG2E), 1e30f);
                            rt[4 * n + i] = (1.0f + eb) * __builtin_amdgcn_rcpf(1.0f + ea); sb[4 * n + i] = __builtin_amdgcn_rcpf(1.0f + eb);
                        }
                    u32x4 w; w.x = cvt_pk_bf16(rt[0], rt[1]); w.y = cvt_pk_bf16(rt[2], rt[3]); w.z = cvt_pk_bf16(rt[4], rt[5]); w.w = cvt_pk_bf16(rt[6], rt[7]);
                    *(u32x4*)(o.RAT + (size_t)row * 1024 + col) = w;
                    w.x = cvt_pk_bf16(sb[0], sb[1]); w.y = cvt_pk_bf16(sb[2], sb[3]); w.z = cvt_pk_bf16(sb[4], sb[5]); w.w = cvt_pk_bf16(sb[6], sb[7]);
                    *(u32x4*)(o.SGB + (size_t)row * 1024 + col) = w;
                }
            return;
        }
#pragma unroll
        for (int bj = 0; bj < 2; ++bj) {
            const int j8 = bj * HALF + wc * 32 + 8 * fq;
            bf16_t* dst = nullptr; int pitch = 0, col = 0, lay = 0, hh = 0, d0 = 0; bool rope_t = false, wi = false; float scale = 1.0f;
            if (pn < 2)       { dst = o.QAB; pitch = 1024; col = 256 * pn + j8; scale = QSCALE; }
            else if (pn < 4)  { dst = o.KA; lay = 1; col = 256 * (pn - 2) + j8; hh = col >> 6; d0 = col & 63; }
            else if (pn < 6)  { dst = o.VA; lay = 2; col = 256 * (pn - 4) + j8; hh = col >> 6; d0 = col & 63; }
            else if (pn < 8)  { dst = o.QAB; pitch = 1024; col = 512 + 256 * (pn - 6) + j8; scale = QSCALE; rope_t = true; }
            else if (pn == 8) { if (bj == 0) { dst = o.KB; lay = 3; hh = j8 >> 6; d0 = j8 & 63; rope_t = true; } else { dst = o.KB; lay = 4; hh = (j8 - HALF) >> 6; d0 = (j8 - HALF) & 63; } }
            else if (pn < 11) { dst = o.QI; pitch = 512; col = 256 * (pn - 9) + j8; rope_t = true; }
            else if (pn == 11) { if (bj == 0 && wc < 2) { dst = o.KI; lay = 5; d0 = j8; rope_t = true; } else if (bj == 0 && wc == 2) { wi = true; } }
            const bool rope_w = rope_t && ((wc & 1) == 0);
            if (dst == nullptr && !wi) continue;
#pragma unroll
            for (int ai = 0; ai < 2; ++ai)
#pragma unroll
                for (int m = 0; m < 4; ++m) {
                    const int row = row0 + ai * HALF + m * 16; const float rs = (u.pm == rl_pm) ? rl[row - rl_pm * BM] : row_rstd(ssq, row);
                    float v[8];
#pragma unroll
                    for (int n = 0; n < 2; ++n)
#pragma unroll
                        for (int i = 0; i < 4; ++i) v[4 * n + i] = acc[ai][bj][m][n][i] * rs;
                    if (rope_w) {
                        const float* rt = o.rope + (size_t)(row & 4095) * 16 + 4 * (fq & 1);
                        const f32x4 cs = *(const f32x4*)rt, sn = *(const f32x4*)(rt + 8);
                        if (fq < 2) {
#pragma unroll
                            for (int i = 0; i < 4; ++i) { const float a = v[i], b = v[4 + i]; v[i] = a * cs[i] - b * sn[i]; v[4 + i] = b * cs[i] + a * sn[i]; }
                        }
                    }
                    if (wi) {
                        if (fq == 0) { float* wp = o.WI + (size_t)row * 8; *(f32x4*)wp = (f32x4){v[0] * WSCALE, v[1] * WSCALE, v[2] * WSCALE, v[3] * WSCALE}; *(f32x4*)(wp + 4) = (f32x4){v[4] * WSCALE, v[5] * WSCALE, v[6] * WSCALE, v[7] * WSCALE}; }
                    } else {
                        u32x4 w; w.x = cvt_pk_bf16(v[0] * scale, v[1] * scale); w.y = cvt_pk_bf16(v[2] * scale, v[3] * scale); w.z = cvt_pk_bf16(v[4] * scale, v[5] * scale); w.w = cvt_pk_bf16(v[6] * scale, v[7] * scale);
                        size_t eo;
                        const int bq = row >> 12, sq = row & 4095, tq = sq >> 6, kq = sq & 63;
                        if (lay == 0) eo = (size_t)row * pitch + col;
                        else if (lay == 1) eo = ((size_t)((bq * 64 + tq) * 8 + hh) * 8 + (d0 >> 3)) * 512 + kq * 8;
                        else if (lay == 2) eo = ((size_t)((bq * 64 + tq) * 8 + hh) * 8 + (d0 >> 5) * 4 + (kq >> 4)) * 512 + (kq & 15) * 32 + (d0 & 31);
                        else if (lay == 3) eo = (size_t)(bq * 64 + tq) * 16384 + hh * 4096 + (d0 >> 3) * 512 + kq * 8;
                        else if (lay == 4) eo = (size_t)(bq * 64 + tq) * 16384 + 8192 + hh * 4096 + ((d0 >> 5) * 4 + (kq >> 4)) * 512 + (kq & 15) * 32 + (d0 & 31);
                        else eo = ((size_t)(bq * 128 + (sq >> 5)) * 8 + (d0 >> 3)) * 256 + (sq & 31) * 8;
                        *(u32x4*)(dst + eo) = w;
                    }
                }
        }
    }
};

struct EpiGate {
    static constexpr bool PERM = true, AFTER_DRAIN = false, HAS_MID = true;
    const bf16_t* RAT; const bf16_t* SGB; bf16_t* MG;
    __device__ __forceinline__ void scale(f32x4 (&acc)[2][2][4][2], const bf16_t* T, const Unit& u, int wr, int wc, int fr, int fq) const {
        unsigned base = (unsigned)(u.pm * BM + wr * 64 + fr) * 1024u + (unsigned)(u.pn * BM + wc * 32 + 8 * fq);
        asm volatile("" : "+v"(base));
#pragma unroll
        for (int ai = 0; ai < 2; ++ai)
#pragma unroll
            for (int m = 0; m < 4; ++m) {
#pragma unroll
                for (int bj = 0; bj < 2; ++bj) {
                    const unsigned off = base + (unsigned)((ai * HALF + m * 16) * 1024 + bj * HALF);
                    const u32x4 a = *(const u32x4*)(T + off);
                    acc[ai][bj][m][0][0] *= bf_lo(a.x); acc[ai][bj][m][0][1] *= bf_hi(a.x); acc[ai][bj][m][0][2] *= bf_lo(a.y); acc[ai][bj][m][0][3] *= bf_hi(a.y);
                    acc[ai][bj][m][1][0] *= bf_lo(a.z); acc[ai][bj][m][1][1] *= bf_hi(a.z); acc[ai][bj][m][1][2] *= bf_lo(a.w); acc[ai][bj][m][1][3] *= bf_hi(a.w);
                }
                asm volatile("" ::: "memory");
            }
    }
    __device__ __forceinline__ void mid(f32x4 (&acc)[2][2][4][2], const Unit& u, int wr, int wc, int fr, int fq) const { scale(acc, RAT, u, wr, wc, fr, fq); }
    __device__ __forceinline__ void operator()(f32x4 (&acc)[2][2][4][2], const Unit& u, int wr, int wc, int fr, int fq) const {
        scale(acc, SGB, u, wr, wc, fr, fq);
        const int row0 = u.pm * BM + wr * 64 + fr, col0 = u.pn * BM + wc * 32 + 8 * fq;
#pragma unroll
        for (int ai = 0; ai < 2; ++ai)
#pragma unroll
            for (int m = 0; m < 4; ++m)
#pragma unroll
                for (int bj = 0; bj < 2; ++bj) {
                    const size_t off = (size_t)(row0 + ai * HALF + m * 16) * 1024 + col0 + bj * HALF;
                    const f32x4 v0 = acc[ai][bj][m][0], v1 = acc[ai][bj][m][1];
                    u32x4 w; w.x = cvt_pk_bf16(v0[0], v0[1]); w.y = cvt_pk_bf16(v0[2], v0[3]); w.z = cvt_pk_bf16(v1[0], v1[1]); w.w = cvt_pk_bf16(v1[2], v1[3]);
                    *(u32x4*)(MG + off) = w;
                }
    }
};


struct EpiFinal {
    static constexpr bool PERM = true, AFTER_DRAIN = true, HAS_MID = false;
    const bf16_t* base; float* out; float* ssq_out; const float* g; float alpha; const XcdBarrier* bar;
    __device__ __forceinline__ void fused(f32x4 (&acc)[2][2][4][2], const Unit& u, int wr, int wc, int fr, int fq, PG8_LAS unsigned char* lds, int wid, int lane) const {
        const int row0 = u.pm * BM + wr * 64 + fr, col0 = u.pn * BM + wc * 32 + 8 * fq;
#pragma unroll
        for (int ai = 0; ai < 2; ++ai)
#pragma unroll
            for (int m = 0; m < 4; ++m) {
                const int row = row0 + ai * HALF + m * 16; float ss = 0.f;
#pragma unroll
                for (int bj = 0; bj < 2; ++bj) {
                    const size_t off = (size_t)row * 1024 + col0 + bj * HALF;
                    const u32x4 w = *(const u32x4*)(base + off);
                    const f32x4 b0 = (f32x4){bf_lo(w.x), bf_hi(w.x), bf_lo(w.y), bf_hi(w.y)}, b1 = (f32x4){bf_lo(w.z), bf_hi(w.z), bf_lo(w.w), bf_hi(w.w)};
                    const f32x4 v0 = b0 + acc[ai][bj][m][0] * alpha, v1 = b1 + acc[ai][bj][m][1] * alpha;
                    acc[ai][bj][m][0] = v0; acc[ai][bj][m][1] = v1;
                    ss += ((v0[0] * v0[0] + v0[1] * v0[1]) + (v0[2] * v0[2] + v0[3] * v0[3])) + ((v1[0] * v1[0] + v1[1] * v1[1]) + (v1[2] * v1[2] + v1[3] * v1[3]));
                }
                ss += __shfl_xor(ss, 16); ss += __shfl_xor(ss, 32);
                if (fq == 0) ssq_out[(size_t)row * 16 + u.pn * 4 + wc] = ss;
                if (m & 1) asm volatile("" ::: "memory");
            }
        xcd_barrier(*bar);
        f32x4 gv[2][2];
#pragma unroll
        for (int bj = 0; bj < 2; ++bj) { gv[bj][0] = *(const f32x4*)(g + col0 + bj * HALF); gv[bj][1] = *(const f32x4*)(g + col0 + bj * HALF + 4); }
#pragma unroll
        for (int ai = 0; ai < 2; ++ai)
#pragma unroll
            for (int m = 0; m < 4; ++m) {
                const int row = row0 + ai * HALF + m * 16; const float rs = row_rstd(ssq_out, row);
#pragma unroll
                for (int bj = 0; bj < 2; ++bj) {
                    const size_t off = (size_t)row * 1024 + col0 + bj * HALF;
                    *(f32x4*)(out + off) = acc[ai][bj][m][0] * rs * gv[bj][0]; *(f32x4*)(out + off + 4) = acc[ai][bj][m][1] * rs * gv[bj][1];
                }
            }
    }
};
template <class Epi, class Sched, bool ALIGN_EPI = false, bool SP2 = false>
__device__ __forceinline__ void gemm_phase(PG8_LAS unsigned char* lds, const Gemm g, const Sched& S, const Epi& E) {
    const int tid = threadIdx.x, wid = __builtin_amdgcn_readfirstlane(tid >> 6), lane = tid & 63, wr = wid >> 2, wc = wid & 3, fr = lane & 15, fq = lane >> 4;
    const int K = g.K, nt = K / BK;
    unsigned voffA[2], voffB[2];
#pragma unroll
    for (int i = 0; i < 2; ++i) { int R, C; stage_rc(tid * 16 + i * 8192, R, C); const int Rb = Epi::PERM ? ((R & ~31) + perm32(R & 31)) : R;
        voffA[i] = (unsigned)(R * K + C) * 2u; voffB[i] = (unsigned)(Rb * K + C) * 2u; }
    const size_t kstep = (size_t)(BK * 2);
    const size_t hstep = (size_t)HALF * K * 2;
    const size_t tstep = 2 * hstep;
    const unsigned ldsw = (unsigned)wid * 1024u;
    const int aoff = lds_byte(wr * 64 + fr, fq * 8), boff = lds_byte(wc * 32 + fr, fq * 8);
#define PG8_SA(b, h) (((b) * 2 + (h)) * HTB)
#define PG8_SB(b, h) ((4 + (b) * 2 + (h)) * HTB)
#define PG8_STAGE(bufoff, gbase, voff) do { _Pragma("unroll") for (int _i = 0; _i < 2; ++_i) \
        __builtin_amdgcn_global_load_lds((const unsigned*)((const char*)(gbase) + (voff)[_i]), (PG8_LAS unsigned*)(lds + (bufoff) + ldsw + _i * 8192), 16, 0, 0); } while (0)
#define PG8_LDA(dst, b, h) do { _Pragma("unroll") for (int m = 0; m < 4; ++m) _Pragma("unroll") for (int k = 0; k < 2; ++k) dst[m][k] = *(const PG8_LAS bf16x8*)(lds + PG8_SA(b, h) + aoff + m * 2048 + k * 1024); } while (0)
#define PG8_LDB(dst, b, h) do { _Pragma("unroll") for (int n = 0; n < 2; ++n) _Pragma("unroll") for (int k = 0; k < 2; ++k) dst[n][k] = *(const PG8_LAS bf16x8*)(lds + PG8_SB(b, h) + boff + n * 2048 + k * 1024); } while (0)
#define PG8_MMA(ai, bj, At, Bt) do { __builtin_amdgcn_s_setprio(1); _Pragma("unroll") for (int m = 0; m < 4; ++m) _Pragma("unroll") for (int n = 0; n < 2; ++n) _Pragma("unroll") for (int k = 0; k < 2; ++k) \
        acc[ai][bj][m][n] = __builtin_amdgcn_mfma_f32_16x16x32_bf16(Bt[n][k], At[m][k], acc[ai][bj][m][n], 0, 0, 0); __builtin_amdgcn_s_setprio(0); } while (0)
#define PG8_WAIT_V(n) asm volatile("s_waitcnt vmcnt(" #n ")" ::: "memory")
#define PG8_WAIT_L(n) asm volatile("s_waitcnt lgkmcnt(" #n ")" ::: "memory")
#define PG8_BAR __builtin_amdgcn_s_barrier()
#define PG8_SCHED __builtin_amdgcn_sched_barrier(0)
    Unit cur, nxt; int ui = 0;
    if (!S.next(0, cur)) return;
    f32x4 acc[2][2][4][2];
#pragma unroll
    for (int a = 0; a < 2; ++a)
#pragma unroll
        for (int b = 0; b < 2; ++b)
#pragma unroll
            for (int m = 0; m < 4; ++m)
#pragma unroll
                for (int n = 0; n < 2; ++n) acc[a][b][m][n] = (f32x4){0.f, 0.f, 0.f, 0.f};
    bf16x8 At[4][2], B0[2][2], B1[2][2];
    const char* cA = (const char*)g.A + (size_t)cur.pm * tstep; const char* cB = (const char*)g.Bt + (size_t)cur.pn * tstep;
    S.a_ready(cur);
    if constexpr (SP2) {
        PG8_STAGE(PG8_SB(0, 0), cB, voffB); PG8_STAGE(PG8_SB(0, 1), cB + hstep, voffB); PG8_STAGE(PG8_SA(0, 0), cA, voffA); PG8_STAGE(PG8_SA(0, 1), cA + hstep, voffA);
        if (wr == 1) PG8_BAR;
        PG8_WAIT_V(2); PG8_BAR;
        PG8_STAGE(PG8_SB(1, 0), cB + kstep, voffB); PG8_STAGE(PG8_SA(1, 0), cA + kstep, voffA); PG8_STAGE(PG8_SB(1, 1), cB + hstep + kstep, voffB);
        PG8_WAIT_V(6); PG8_BAR;
    } else {
        PG8_STAGE(PG8_SB(0, 0), cB, voffB); PG8_STAGE(PG8_SA(0, 0), cA, voffA); PG8_STAGE(PG8_SB(0, 1), cB + hstep, voffB); PG8_STAGE(PG8_SA(0, 1), cA + hstep, voffA);
        if (wr == 1) PG8_BAR;
        PG8_WAIT_V(4); PG8_BAR;
        PG8_STAGE(PG8_SB(1, 0), cB + kstep, voffB); PG8_STAGE(PG8_SA(1, 0), cA + kstep, voffA); PG8_STAGE(PG8_SB(1, 1), cB + hstep + kstep, voffB);
        PG8_WAIT_V(6); PG8_BAR;
    }
    for (;;) {
        const bool has_next = S.next(ui + 1, nxt);
        const char* nA = has_next ? (const char*)g.A + (size_t)nxt.pm * tstep : cA; const char* nB = has_next ? (const char*)g.Bt + (size_t)nxt.pn * tstep : cB;
        for (int t = 0; t < nt; t += 2) {
            if constexpr (Epi::HAS_MID) { if (t == (nt >> 1)) E.mid(acc, cur, wr, wc, fr, fq); }
            const bool last = (t == nt - 2);
            const char* a1 = cA + (size_t)(t + 1) * kstep;
            const char* a2 = last ? nA : cA + (size_t)(t + 2) * kstep; const char* b2 = last ? nB : cB + (size_t)(t + 2) * kstep;
            const char* a3 = a2 + kstep; const char* b3 = b2 + kstep;
            if (last && has_next) S.a_ready(nxt);
            if constexpr (SP2) {
            PG8_LDB(B0, 0, 0); PG8_LDB(B1, 0, 1); PG8_SCHED; PG8_LDA(At, 0, 0); PG8_STAGE(PG8_SA(1, 1), a1 + hstep, voffA);
            PG8_WAIT_V(8); PG8_WAIT_L(0); PG8_BAR; PG8_MMA(0, 0, At, B0); PG8_MMA(0, 1, At, B1); PG8_BAR; PG8_SCHED;
            PG8_LDA(At, 0, 1); PG8_STAGE(PG8_SB(0, 0), b2, voffB); PG8_STAGE(PG8_SB(0, 1), b2 + hstep, voffB); PG8_STAGE(PG8_SA(0, 0), a2, voffA);
            PG8_WAIT_V(8); PG8_WAIT_L(0); PG8_BAR; PG8_MMA(1, 0, At, B0); PG8_MMA(1, 1, At, B1); PG8_BAR; PG8_SCHED;
            PG8_LDB(B0, 1, 0); PG8_LDB(B1, 1, 1); PG8_SCHED; PG8_LDA(At, 1, 0); PG8_STAGE(PG8_SA(0, 1), a2 + hstep, voffA);
            PG8_WAIT_V(8); PG8_WAIT_L(0); PG8_BAR; PG8_MMA(0, 0, At, B0); PG8_MMA(0, 1, At, B1); PG8_BAR; PG8_SCHED;
            PG8_LDA(At, 1, 1); PG8_STAGE(PG8_SB(1, 0), b3, voffB); PG8_STAGE(PG8_SB(1, 1), b3 + hstep, voffB); PG8_STAGE(PG8_SA(1, 0), a3, voffA);
            PG8_WAIT_V(8); PG8_WAIT_L(0); PG8_BAR; PG8_MMA(1, 0, At, B0); PG8_MMA(1, 1, At, B1); PG8_BAR; PG8_SCHED;
            } else {
            PG8_LDB(B0, 0, 0); PG8_SCHED; PG8_LDA(At, 0, 0); PG8_STAGE(PG8_SA(1, 1), a1 + hstep, voffA);
            PG8_WAIT_L(8); PG8_BAR; PG8_WAIT_L(0); PG8_MMA(0, 0, At, B0); PG8_BAR; PG8_SCHED;
            PG8_LDB(B1, 0, 1); PG8_STAGE(PG8_SB(0, 0), b2, voffB);
            PG8_BAR; PG8_WAIT_L(0); PG8_MMA(0, 1, At, B1); PG8_BAR;
            PG8_LDA(At, 0, 1); PG8_STAGE(PG8_SA(0, 0), a2, voffA);
            PG8_BAR; PG8_WAIT_L(0); PG8_MMA(1, 0, At, B0); PG8_BAR; PG8_SCHED;
            PG8_STAGE(PG8_SB(0, 1), b2 + hstep, voffB);
            PG8_WAIT_V(6); PG8_BAR; PG8_MMA(1, 1, At, B1); PG8_BAR;
            PG8_LDB(B0, 1, 0); PG8_SCHED; PG8_LDA(At, 1, 0); PG8_STAGE(PG8_SA(0, 1), a2 + hstep, voffA);
            PG8_WAIT_L(8); PG8_BAR; PG8_WAIT_L(0); PG8_MMA(0, 0, At, B0); PG8_BAR; PG8_SCHED;
            PG8_LDB(B1, 1, 1); PG8_STAGE(PG8_SB(1, 0), b3, voffB);
            PG8_BAR; PG8_WAIT_L(0); PG8_MMA(0, 1, At, B1); PG8_BAR;
            PG8_LDA(At, 1, 1); PG8_STAGE(PG8_SA(1, 0), a3, voffA);
            PG8_BAR; PG8_WAIT_L(0); PG8_MMA(1, 0, At, B0); PG8_BAR; PG8_SCHED;
            PG8_STAGE(PG8_SB(1, 1), b3 + hstep, voffB);
            PG8_WAIT_V(6); PG8_BAR; PG8_MMA(1, 1, At, B1); PG8_BAR;
            }
        }
        if constexpr (ALIGN_EPI) { if (wr == 0) PG8_BAR; }
        if constexpr (!Epi::AFTER_DRAIN) { E(acc, cur, wr, wc, fr, fq); S.done(cur); }
        if (!has_next) break;
#pragma unroll
        for (int a = 0; a < 2; ++a)
#pragma unroll
            for (int b = 0; b < 2; ++b)
#pragma unroll
                for (int m = 0; m < 4; ++m)
#pragma unroll
                    for (int n = 0; n < 2; ++n) acc[a][b][m][n] = (f32x4){0.f, 0.f, 0.f, 0.f};
        cur = nxt; cA = nA; cB = nB; ++ui;
        if constexpr (ALIGN_EPI) { if (wr == 1) PG8_BAR; }
    }
    PG8_WAIT_V(0);
    if constexpr (!ALIGN_EPI) { if (wr == 0) PG8_BAR; }
    PG8_BAR;
    if constexpr (Epi::AFTER_DRAIN) { E.fused(acc, cur, wr, wc, fr, fq, lds, wid, lane); S.done(cur); }
#undef PG8_SA
#undef PG8_SB
#undef PG8_STAGE
#undef PG8_LDA
#undef PG8_LDB
#undef PG8_MMA
#undef PG8_WAIT_V
#undef PG8_WAIT_L
#undef PG8_BAR
#undef PG8_SCHED
}
}

constexpr int NWAVES = 8;
constexpr int NB = 4, SEQ = 4096, D = 1024, M = NB * SEQ, FF = 2816, DIN = 4936, NPROJ = 5120;
constexpr int C_QA = 0, C_KA = 512, C_VA = 1024, C_QB = 1536, C_KB = 2048, C_VB = 2176, C_QI = 2304, C_KI = 2816, C_WI = 2880, C_GA = 2888, C_GB = 3912;

constexpr size_t MiB = 1u << 20;
constexpr size_t WS_CTL = 0, CTL_ZERO_BYTES = 1 * MiB;
constexpr size_t WS_ROPE = 1 * MiB;
constexpr size_t WS_SSQ = 2 * MiB;
constexpr size_t WS_W1 = 6 * MiB, WS_W2 = 17 * MiB, WS_WIN = 23 * MiB, WS_WAB = 33 * MiB, WS_WO = 35 * MiB, WS_W3 = 37 * MiB, WS_W4 = 48 * MiB;
constexpr size_t WS_XB = 54 * MiB;
constexpr size_t WS_MASK = 86 * MiB;
constexpr size_t WS_R = 94 * MiB;
constexpr size_t R_QAB = 0, R_KA = 32 * MiB, R_VA = 48 * MiB, R_KB = 64 * MiB, R_VB = 68 * MiB, R_QI = 72 * MiB, R_KI = 88 * MiB, R_WI = 90 * MiB, R_RAT = 91 * MiB, R_SGB = 123 * MiB, R_END = 155 * MiB;
constexpr size_t R_MG = 32 * MiB;
constexpr size_t WS_END = 256 * MiB;
static_assert(WS_R + R_END <= WS_END && WS_W4 + (size_t)D * FF * 2 <= WS_XB && WS_W1 + (size_t)2 * FF * D * 2 <= WS_W2 && WS_W2 + (size_t)D * FF * 2 <= WS_WIN && WS_WIN + (size_t)NPROJ * D * 2 <= WS_WAB, "d_ws map");
static_assert(WS_W3 + (size_t)2 * FF * D * 2 <= WS_W4 && (size_t)M * FF * 2 <= R_END && WS_XB + (size_t)M * D * 2 <= WS_MASK && WS_MASK + (size_t)M * 128 * 4 <= WS_R, "d_ws map 2");
constexpr int CW_BAR = 4096;

constexpr int RING_OFF = 0, RING_BYTES = 131072;
constexpr int LDSCTL_OFF = 159744, MISC_OFF = LDSCTL_OFF + 320;
constexpr int LDS_BYTES = 163840;
static_assert(MISC_OFF + 128 <= LDS_BYTES, "LDS map");

struct Frame {
    LAS unsigned char* lds;
    volatile LAS unsigned* MISC;
    gu32* ctl;
    int tid, lane, wave, vcu, G;
};

__device__ __forceinline__ float wave_sum(float v) {
#pragma unroll
    for (int o = 1; o < 64; o <<= 1) v += __shfl_xor(v, o);
    return v;
}
__device__ __forceinline__ int rope_perm(int pos) { if (pos >= 16) return pos; const int grp = pos >> 3, i = pos & 7; return (i < 4) ? (4 * grp + i) : (8 + 4 * grp + (i - 4)); }
__device__ __forceinline__ int proj_src_col(int r) {
    const int pn = r >> 8, j = r & 255;
    if (pn < 2) return C_QA + r;
    if (pn < 4) return C_KA + (r - 512);
    if (pn < 6) return C_VA + (r - 1024);
    if (pn < 8) { const int c = r - 1536; return C_QB + (c & ~63) + rope_perm(c & 63); }
    if (pn == 8) { if (j < 128) return C_KB + (j & ~63) + rope_perm(j & 63); return C_VB + (j - 128); }
    if (pn < 11) { const int c = r - 2304; return C_QI + (c & ~63) + rope_perm(c & 63); }
    if (pn == 11) { if (j < 64) return C_KI + rope_perm(j); if (j < 72) return C_WI + (j - 64); return -1; }
    return (j < 128) ? C_GA + 128 * (pn - 12) + j : C_GB + 128 * (pn - 12) + (j - 128);
}
__device__ __forceinline__ void p0_transpose_item(const float* W, int Nsrc, int nblk, const float* g, int kind, bf16* WT, int Kdst, int koff, LAS float* scr, int item, int lane) {
    const int kb = item / nblk, nb = item % nblk, k0 = 64 * kb, n0 = 32 * nb;
    const int r = n0 + 4 * (lane & 7);
    int sc;
    if (kind == 0) sc = r; else if (kind == 1) { const int pn = r >> 8, bj = (r >> 7) & 1, j = r & 127; sc = bj * FF + 128 * pn + j; } else sc = proj_src_col(r);
#pragma unroll
    for (int i = 0; i < 8; ++i) {
        const int kk = (lane >> 3) + 8 * i;
        f32x4 v = (f32x4){0.f, 0.f, 0.f, 0.f};
        if (sc >= 0) v = __builtin_nontemporal_load((const f32x4*)(W + (size_t)(k0 + kk) * Nsrc + sc));
        if (g) v = v * g[k0 + kk];
        LAS float* d = scr + kk * 33 + 4 * (lane & 7);
        d[0] = v.x; d[1] = v.y; d[2] = v.z; d[3] = v.w;
    }
    LDS_WAIT(); asm volatile("" ::: "memory");
    const int c = lane & 7;
#pragma unroll
    for (int j = 0; j < 4; ++j) { const int n = (lane >> 3) + 8 * j; const LAS float* s = scr + (8 * c) * 33 + n;
        v4u o; o.x = pk2(s[0 * 33], s[1 * 33]); o.y = pk2(s[2 * 33], s[3 * 33]); o.z = pk2(s[4 * 33], s[5 * 33]); o.w = pk2(s[6 * 33], s[7 * 33]);
        *(GAS v4u*)(WT + (size_t)(n0 + n) * Kdst + koff + k0 + 8 * c) = o; }
    LDS_WAIT(); asm volatile("" ::: "memory");
}
__device__ __forceinline__ void x_row_to_bf16(const float* xrow, bf16* orow, float* ssqrow, int lane) {
    const GAS f32x4* xr = (const GAS f32x4*)xrow + 2 * lane;
    f32x4 v[4]; float s = 0.f;
#pragma unroll
    for (int j = 0; j < 2; ++j) { v[2 * j] = __builtin_nontemporal_load(xr + 128 * j); v[2 * j + 1] = __builtin_nontemporal_load(xr + 128 * j + 1); }
#pragma unroll
    for (int j = 0; j < 4; ++j) s += (v[j].x * v[j].x + v[j].y * v[j].y) + (v[j].z * v[j].z + v[j].w * v[j].w);
    s = wave_sum(s);
    GAS v4u* o16 = (GAS v4u*)orow + lane;
#pragma unroll
    for (int j = 0; j < 2; ++j) { v4u o; o.x = pk2(v[2 * j].x, v[2 * j].y); o.y = pk2(v[2 * j].z, v[2 * j].w); o.z = pk2(v[2 * j + 1].x, v[2 * j + 1].y); o.w = pk2(v[2 * j + 1].z, v[2 * j + 1].w); o16[64 * j] = o; }
    if (lane < 16) ssqrow[lane] = (lane == 0) ? s : 0.f;
}

struct Args { const float* in[14]; float* out; unsigned char* ws; int ph_lo, ph_hi; };

__device__ __forceinline__ void convert_weights(Frame& F, const Args& a, int set, int gw, int NGW) {
    unsigned char* ws = a.ws;
    LAS float* scr = (LAS float*)(F.lds + RING_OFF + F.wave * 16384);
    constexpr int I_1 = (D / 64) * (2 * FF / 32), I_2 = (FF / 64) * (D / 32), I_IN = (D / 64) * (NPROJ / 32), I_AB = (512 / 64) * (D / 32), I_O = (D / 64) * (D / 32);
    if (set == 0) {
        for (int it = gw; it < I_1 + I_2 + I_IN; it += NGW) {
            int r = it;
            if (r < I_1) { p0_transpose_item(a.in[2], 2 * FF, 2 * FF / 32, a.in[1], 1, (bf16*)(ws + WS_W1), D, 0, scr, r, F.lane); continue; } r -= I_1;
            if (r < I_2) { p0_transpose_item(a.in[3], D, D / 32, nullptr, 0, (bf16*)(ws + WS_W2), FF, 0, scr, r, F.lane); continue; } r -= I_2;
            p0_transpose_item(a.in[5], DIN, NPROJ / 32, a.in[4], 2, (bf16*)(ws + WS_WIN), D, 0, scr, r, F.lane);
        }
    } else if (set == 1) {
        for (int it = gw; it < 2 * I_AB + I_O + I_1; it += NGW) {
            int r = it;
            if (r < I_AB) { p0_transpose_item(a.in[7], D, D / 32, nullptr, 0, (bf16*)(ws + WS_WAB), D, 0, scr, r, F.lane); continue; } r -= I_AB;
            if (r < I_AB) { p0_transpose_item(a.in[8], D, D / 32, nullptr, 0, (bf16*)(ws + WS_WAB), D, 512, scr, r, F.lane); continue; } r -= I_AB;
            if (r < I_O) { p0_transpose_item(a.in[9], D, D / 32, nullptr, 0, (bf16*)(ws + WS_WO), D, 0, scr, r, F.lane); continue; } r -= I_O;
            p0_transpose_item(a.in[11], 2 * FF, 2 * FF / 32, a.in[10], 1, (bf16*)(ws + WS_W3), D, 0, scr, r, F.lane);
        }
    } else {
        for (int it = gw; it < I_2; it += NGW) p0_transpose_item(a.in[12], D, D / 32, nullptr, 0, (bf16*)(ws + WS_W4), FF, 0, scr, it, F.lane);
    }
}
__device__ __forceinline__ bool tail_convert(const Frame& F) { return F.G == 256; }
__device__ __forceinline__ void p0_prologue(Frame& F, const Args& a) {
    unsigned char* ws = a.ws;
    const int gw = F.vcu * NWAVES + F.wave, NGW = F.G * NWAVES;
    convert_weights(F, a, 0, gw, NGW);
    if (!tail_convert(F)) { convert_weights(F, a, 1, gw, NGW); convert_weights(F, a, 2, gw, NGW); }
    for (int m = gw; m < M; m += NGW) x_row_to_bf16(a.in[0] + (size_t)m * D, (bf16*)(ws + WS_XB) + (size_t)m * D, (float*)(ws + WS_SSQ) + (size_t)m * 16, F.lane);
    float* rope = (float*)(ws + WS_ROPE);
    for (int i = F.vcu * (NWAVES * 64) + F.tid; i < SEQ * 8; i += F.G * NWAVES * 64) {
        const int s = i >> 3, j = i & 7;
        const float inv = powf(500000.0f, -(float)(2 * j) / 16.0f), ang = (float)s * inv;
        rope[s * 16 + j] = cosf(ang); rope[s * 16 + 8 + j] = sinf(ang);
    }
}

constexpr int RSTD_OFF = RING_BYTES;
__device__ __forceinline__ int fill_rstd_table(Frame& F, const float* ssq, const pg8::StaticOrder& S) {
    pg8::Unit u; if (!S.next(0, u)) return -1;
    if (F.tid < 256) ((LAS float*)(F.lds + RSTD_OFF))[F.tid] = pg8::row_rstd(ssq, u.pm * 256 + F.tid);
    __syncthreads();
    return u.pm;
}
__device__ __forceinline__ void p9_final(Frame& F, float* out, const float* ssq, const float* g) {
    const int gw = F.vcu * NWAVES + F.wave, NGW = F.G * NWAVES;
    for (int m = gw; m < M; m += NGW) {
        const float rs = pg8::row_rstd(ssq, m);
        GAS f32x4* xr = (GAS f32x4*)(out + (size_t)m * D) + F.lane; const f32x4* gr = (const f32x4*)g + F.lane;
#pragma unroll
        for (int j = 0; j < 4; ++j) { const f32x4 v = xr[64 * j], gg = gr[64 * j]; xr[64 * j] = v * rs * gg; }
    }
}


namespace mx {
typedef float f32x16 __attribute__((ext_vector_type(16)));
typedef short v4i16_t __attribute__((ext_vector_type(4)));
typedef __attribute__((address_space(3))) unsigned char* lptr;
typedef __attribute__((address_space(3))) const unsigned char* lcptr;
constexpr float LOG2E = 1.4426950408889634f;
constexpr float THR = 8.0f;
__device__ __forceinline__ int crow(int r, int hi) { return (r & 3) + 8 * (r >> 2) + 4 * hi; }
typedef float cv_f32x2_t __attribute__((ext_vector_type(2))); typedef __bf16 cv_bf16x2_t __attribute__((ext_vector_type(2)));
__device__ __forceinline__ unsigned cvtpk(float lo, float hi) { const cv_f32x2_t v = {lo, hi}; const cv_bf16x2_t b = __builtin_convertvector(v, cv_bf16x2_t); return __builtin_bit_cast(unsigned, b); }
__device__ __forceinline__ bf16x8 pack8(const f32x16& p, int b) {
    v4u w; w.x = cvtpk(p[b + 0], p[b + 1]); w.y = cvtpk(p[b + 2], p[b + 3]); w.z = cvtpk(p[b + 4], p[b + 5]); w.w = cvtpk(p[b + 6], p[b + 7]);
    return __builtin_bit_cast(bf16x8, w);
}
__device__ __forceinline__ bf16x8 vfrag(lcptr p) {
    const v4i16_t lo = __builtin_amdgcn_ds_read_tr16_b64_v4i16((__attribute__((address_space(3))) v4i16_t*)p);
    const v4i16_t hi = __builtin_amdgcn_ds_read_tr16_b64_v4i16((__attribute__((address_space(3))) v4i16_t*)(p + 512));
    return (bf16x8){lo[0], lo[1], lo[2], lo[3], hi[0], hi[1], hi[2], hi[3]};
}
__device__ __forceinline__ void glds16(const void* gsrc, lptr ldst) {
    unsigned keep; const unsigned dst = (unsigned)__builtin_amdgcn_readfirstlane((int)(unsigned)(size_t)ldst);
    asm volatile("s_mov_b32 %0, m0\n\ts_mov_b32 m0, %2\n\ts_nop 0\n\tglobal_load_lds_dwordx4 %1, off\n\ts_mov_b32 m0, %0" : "=&s"(keep) : "v"(gsrc), "s"(dst) : "memory");
}
#define GLDS_WAIT() asm volatile("s_waitcnt vmcnt(0)" ::: "memory")
__device__ __forceinline__ float max3f(float a, float b, float c) { float r; asm("v_max3_f32 %0, %1, %2, %3" : "=v"(r) : "v"(a), "v"(b), "v"(c)); return r; }
__device__ __forceinline__ float max2f(float a, float b) { float r; asm("v_max_f32_e32 %0, %1, %2" : "=v"(r) : "v"(a), "v"(b)); return r; }
__device__ __forceinline__ float relu1(float a) { float r; asm("v_max_f32_e32 %0, 0, %1" : "=v"(r) : "v"(a)); return r; }
struct AttnState { float m, l; f32x16 o0, o1; bool first; };

typedef __bf16 bf16x2_t __attribute__((ext_vector_type(2)));
__device__ __forceinline__ float dot2_ones(unsigned w, float acc) { return __builtin_amdgcn_fdot2_f32_bf16(__builtin_bit_cast(bf16x2_t, w), __builtin_bit_cast(bf16x2_t, 0x3F803F80u), acc, false); }
struct PK { v4u w0, w1, w2, w3; };
struct NoHook { __device__ __forceinline__ void operator()() const {} };
template <int MODE, class Hook = NoHook>
__device__ __forceinline__ void attn_qk(AttnState& st, lcptr Kb, const bf16x8 (&qr)[4], __attribute__((address_space(3))) float* wsf,
                                        const __attribute__((address_space(3))) float* biasl, int delta, lcptr pmask, int lane, PK& pk, const Hook& hook = Hook()) {
    const int r32 = lane & 31, hi = lane >> 5;
    f32x16 p0, p1;
    bool far = false; float cinit = st.first ? 0.f : -st.m;
    if (MODE == 1) { far = (delta - 63 >= 128); if (far) cinit += biasl[256]; }
#pragma unroll
    for (int r = 0; r < 16; ++r) { p0[r] = cinit; p1[r] = cinit; }
    lcptr kp = Kb + hi * 1024 + r32 * 16;
    asm volatile("" : "+v"(kp));
    __builtin_amdgcn_s_setprio(1);
#pragma unroll
    for (int d0 = 0; d0 < 4; ++d0) {
        const bf16x8 a0 = *(const __attribute__((address_space(3))) bf16x8*)(kp + d0 * 2048);
        const bf16x8 a1 = *(const __attribute__((address_space(3))) bf16x8*)(kp + d0 * 2048 + 512);
        p0 = __builtin_amdgcn_mfma_f32_32x32x16_bf16(a0, qr[d0], p0, 0, 0, 0);
        p1 = __builtin_amdgcn_mfma_f32_32x32x16_bf16(a1, qr[d0], p1, 0, 0, 0);
    }
    __builtin_amdgcn_s_setprio(0);
    asm volatile("s_nop 15\n\ts_nop 7" : "+v"(p0), "+v"(p1) :: "memory");
    if (MODE == 1) {
        if (!far) {
            int base = delta + r32 - 4 * hi;
            asm volatile("" : "+v"(base));
#pragma unroll
            for (int r = 0; r < 16; ++r) {
                int d0i = base - ((r & 3) + 8 * (r >> 2)), d1i = d0i - 32;
                d0i = d0i < -128 ? -128 : (d0i > 128 ? 128 : d0i); d1i = d1i < -128 ? -128 : (d1i > 128 ? 128 : d1i);
                p0[r] += biasl[d0i + 128]; p1[r] += biasl[d1i + 128];
                if ((r & 3) == 3) asm volatile("" ::: "memory");
            }
        }
    }
    float ra = max3f(p0[0], p0[1], p1[0]), rb = max3f(p0[2], p0[3], p1[1]);
    ra = max3f(ra, p1[2], p1[3]);
#pragma unroll
    for (int r = 4; r < 16; r += 4) { ra = max3f(ra, p0[r], p0[r + 1]); rb = max3f(rb, p0[r + 2], p0[r + 3]); ra = max3f(ra, p1[r], p1[r + 1]); rb = max3f(rb, p1[r + 2], p1[r + 3]); }
    float rm = max2f(ra, rb);
    { const auto rr = __builtin_amdgcn_permlane32_swap(__float_as_uint(rm), __float_as_uint(rm), false, false); rm = __builtin_fmaxf(__uint_as_float(rr[0]), __uint_as_float(rr[1])); }
    if (st.first || __any(rm > THR)) {
        const float dl = st.first ? rm : __builtin_fmaxf(rm, 0.f);
        if (!st.first) {
            const float f = __builtin_amdgcn_exp2f(-dl);
            st.l *= f;
            if (hi == 0) wsf[r32] = f;
            asm volatile("s_waitcnt lgkmcnt(0)" ::: "memory");
#pragma unroll
            for (int r = 0; r < 16; ++r) { const float fr_ = wsf[crow(r, hi)]; st.o0[r] *= fr_; st.o1[r] *= fr_; }
        }
        st.m = st.first ? dl : st.m + dl; st.first = false;
#pragma unroll
        for (int r = 0; r < 16; ++r) { p0[r] -= dl; p1[r] -= dl; }
    }
    hook();
#pragma unroll
    for (int r = 0; r < 16; ++r) { p0[r] = __builtin_amdgcn_exp2f(p0[r]); p1[r] = __builtin_amdgcn_exp2f(p1[r]); }
    v4u w0, w1, w2, w3;
    w0.x = cvtpk(p0[0], p0[1]); w0.y = cvtpk(p0[2], p0[3]); w0.z = cvtpk(p0[4], p0[5]); w0.w = cvtpk(p0[6], p0[7]);
    w1.x = cvtpk(p0[8], p0[9]); w1.y = cvtpk(p0[10], p0[11]); w1.z = cvtpk(p0[12], p0[13]); w1.w = cvtpk(p0[14], p0[15]);
    w2.x = cvtpk(p1[0], p1[1]); w2.y = cvtpk(p1[2], p1[3]); w2.z = cvtpk(p1[4], p1[5]); w2.w = cvtpk(p1[6], p1[7]);
    w3.x = cvtpk(p1[8], p1[9]); w3.y = cvtpk(p1[10], p1[11]); w3.z = cvtpk(p1[12], p1[13]); w3.w = cvtpk(p1[14], p1[15]);
    if (MODE == 2) {
        lcptr pm = pmask + r32 * 144 + hi * 32;
        asm volatile("" : "+v"(pm));
        const v4u m0 = *(const __attribute__((address_space(3))) v4u*)(pm), m1 = *(const __attribute__((address_space(3))) v4u*)(pm + 16);
        const v4u m2 = *(const __attribute__((address_space(3))) v4u*)(pm + 64), m3 = *(const __attribute__((address_space(3))) v4u*)(pm + 80);
        w0 &= m0; w1 &= m1; w2 &= m2; w3 &= m3;
        float sa = dot2_ones(w0.x, 0.f), sb = dot2_ones(w0.y, 0.f);
        sa = dot2_ones(w0.z, sa); sb = dot2_ones(w0.w, sb); sa = dot2_ones(w1.x, sa); sb = dot2_ones(w1.y, sb); sa = dot2_ones(w1.z, sa); sb = dot2_ones(w1.w, sb);
        sa = dot2_ones(w2.x, sa); sb = dot2_ones(w2.y, sb); sa = dot2_ones(w2.z, sa); sb = dot2_ones(w2.w, sb); sa = dot2_ones(w3.x, sa); sb = dot2_ones(w3.y, sb); sa = dot2_ones(w3.z, sa); sb = dot2_ones(w3.w, sb);
        st.l += sa + sb;
    } else {
        float sa = 0.f, sb = 0.f;
#pragma unroll
        for (int r = 0; r < 16; ++r) { sa += p0[r]; sb += p1[r]; }
        st.l += sa + sb;
    }
    pk.w0 = w0; pk.w1 = w1; pk.w2 = w2; pk.w3 = w3;
}
__device__ __forceinline__ void attn_pv(AttnState& st, lcptr Vb, const PK& pk, int lane) {
    const int hi = lane >> 5;
    const bf16x8 pa0 = __builtin_bit_cast(bf16x8, pk.w0), pa1 = __builtin_bit_cast(bf16x8, pk.w1), pa2 = __builtin_bit_cast(bf16x8, pk.w2), pa3 = __builtin_bit_cast(bf16x8, pk.w3);
    lcptr vp = Vb + ((lane >> 4) & 1) * 32 + (lane & 3) * 8 + (4 * hi + ((lane & 15) >> 2)) * 64;
    asm volatile("" : "+v"(vp));
    __builtin_amdgcn_s_setprio(1);
    st.o0 = __builtin_amdgcn_mfma_f32_32x32x16_bf16(pa0, vfrag(vp + 0 * 1024), st.o0, 0, 0, 0);
    st.o0 = __builtin_amdgcn_mfma_f32_32x32x16_bf16(pa1, vfrag(vp + 1 * 1024), st.o0, 0, 0, 0);
    st.o0 = __builtin_amdgcn_mfma_f32_32x32x16_bf16(pa2, vfrag(vp + 2 * 1024), st.o0, 0, 0, 0);
    st.o0 = __builtin_amdgcn_mfma_f32_32x32x16_bf16(pa3, vfrag(vp + 3 * 1024), st.o0, 0, 0, 0);
    asm volatile("" ::: "memory");
    st.o1 = __builtin_amdgcn_mfma_f32_32x32x16_bf16(pa0, vfrag(vp + 4096 + 0 * 1024), st.o1, 0, 0, 0);
    st.o1 = __builtin_amdgcn_mfma_f32_32x32x16_bf16(pa1, vfrag(vp + 4096 + 1 * 1024), st.o1, 0, 0, 0);
    st.o1 = __builtin_amdgcn_mfma_f32_32x32x16_bf16(pa2, vfrag(vp + 4096 + 2 * 1024), st.o1, 0, 0, 0);
    st.o1 = __builtin_amdgcn_mfma_f32_32x32x16_bf16(pa3, vfrag(vp + 4096 + 3 * 1024), st.o1, 0, 0, 0);
    __builtin_amdgcn_s_setprio(0);
}
__device__ __forceinline__ void expand_pair_masks(const __attribute__((address_space(3))) unsigned* maskl, lptr dst, int t, int tid) {
    const int q = tid >> 4, x = tid & 15, half = x >> 3, hi = (x >> 2) & 1, j = x & 3;
    const unsigned word = maskl[q * 128 + 2 * t + half];
    const unsigned nib = (word >> (8 * j + 4 * hi)) & 0xFu;
    typedef unsigned u32x2_t __attribute__((ext_vector_type(2)));
    u32x2_t o; o.x = ((nib & 1u) ? 0x0000FFFFu : 0u) | ((nib & 2u) ? 0xFFFF0000u : 0u); o.y = ((nib & 4u) ? 0x0000FFFFu : 0u) | ((nib & 8u) ? 0xFFFF0000u : 0u);
    *(__attribute__((address_space(3))) u32x2_t*)(dst + q * 144 + half * 64 + hi * 32 + j * 8) = o;
}
__device__ __forceinline__ void attn_finish(AttnState& st, __attribute__((address_space(3))) float* wsf, lptr stg, bf16* dst, int lane) {
    const int r32 = lane & 31, hi = lane >> 5;
    float l = st.l; l += __shfl_xor(l, 32);
    asm volatile("s_waitcnt lgkmcnt(0)" ::: "memory");
    if (hi == 0) wsf[32 + r32] = l;
    asm volatile("s_waitcnt lgkmcnt(0)" ::: "memory");
    __attribute__((address_space(3))) unsigned short* s16 = (__attribute__((address_space(3))) unsigned short*)stg;
#pragma unroll
    for (int r = 0; r < 16; ++r) {
        const int orow = crow(r, hi); const float rl = __builtin_amdgcn_rcpf(wsf[32 + orow]);
        s16[orow * 64 + r32] = (unsigned short)f2bf(st.o0[r] * rl);
        s16[orow * 64 + 32 + r32] = (unsigned short)f2bf(st.o1[r] * rl);
    }
    asm volatile("s_waitcnt lgkmcnt(0)" ::: "memory");
#pragma unroll
    for (int i = 0; i < 4; ++i) { const int row = i * 8 + (lane >> 3), ch = lane & 7; const v4u v = *(const __attribute__((address_space(3))) v4u*)(stg + row * 128 + ch * 16); *(GAS v4u*)(dst + (size_t)row * 1024 + ch * 8) = v; }
}

constexpr int A_KV = 0, A_WSF = 65536, A_STG = 67584, A_BIAS = 100352;
__device__ __forceinline__ void mixer_a_unit(Frame& F, const bf16* QAB, bf16* OAB, const bf16* KA, const bf16* VA, const float* rel_bias, int b, int jb, int h) {
    int lane = F.lane; asm volatile("" : "+v"(lane));
    const int wid = F.wave, r32 = lane & 31, hi = lane >> 5;
    lptr L = F.lds;
    __attribute__((address_space(3))) float* biasl = (__attribute__((address_space(3))) float*)(L + A_BIAS);
    __attribute__((address_space(3))) float* wsf = (__attribute__((address_space(3))) float*)(L + A_WSF) + wid * 64;
    for (int i = F.tid; i < 257; i += NWAVES * 64) biasl[i] = rel_bias[h * 257 + i] * LOG2E;
    const size_t rowbase = (size_t)b * SEQ; const int qrow0 = jb * 256 + wid * 32, c = 4 * jb + (wid >> 1);
    const bf16* Qw = QAB + (rowbase + qrow0) * 1024 + h * 64; bf16* Ow = OAB + (rowbase + qrow0) * 1024 + h * 64;
    bf16x8 qr[4];
#pragma unroll
    for (int d0 = 0; d0 < 4; ++d0) qr[d0] = *(const bf16x8*)(Qw + (size_t)r32 * 1024 + d0 * 16 + hi * 8);
    const int t_lo = (4 * jb - 8) < 0 ? 0 : (4 * jb - 8), t_hi = 4 * jb + 3;
    const bf16* ksrc = KA + ((size_t)(b * 64) * 8 + h) * 4096 + wid * 512 + lane * 8;
    const bf16* vsrc = VA + ((size_t)(b * 64) * 8 + h) * 4096 + wid * 512 + lane * 8;
    const int pdst = wid * 1024;
    glds16(ksrc + (size_t)t_lo * 32768, L + A_KV + pdst); glds16(vsrc + (size_t)t_lo * 32768, L + A_KV + 8192 + pdst);
    if (t_lo < t_hi) { glds16(ksrc + (size_t)(t_lo + 1) * 32768, L + A_KV + 16384 + pdst); glds16(vsrc + (size_t)(t_lo + 1) * 32768, L + A_KV + 16384 + 8192 + pdst); asm volatile("s_waitcnt vmcnt(2)" ::: "memory"); }
    else GLDS_WAIT();
    __syncthreads();
    AttnState st; st.m = 0.f; st.l = 0.f; st.first = true;
#pragma unroll
    for (int r = 0; r < 16; ++r) { st.o0[r] = 0.f; st.o1[r] = 0.f; }
    const bool late = false; PK pk; bool have = false; int pslot = 0;
    for (int t = t_lo; t <= t_hi; ++t) {
        const int sl = ((t - t_lo) & 3) * 16384;
        if (t + 2 <= t_hi) { const int s2 = ((t + 2 - t_lo) & 3) * 16384; glds16(ksrc + (size_t)(t + 2) * 32768, L + A_KV + s2 + pdst); glds16(vsrc + (size_t)(t + 2) * 32768, L + A_KV + s2 + 8192 + pdst); }
        const bool mine = (c - 8 <= t && t <= c);
        if (!late) { if (mine) { attn_qk<1>(st, L + A_KV + sl, qr, wsf, biasl, qrow0 - 64 * t, nullptr, lane, pk); attn_pv(st, L + A_KV + sl + 8192, pk, lane); } }
        else {
            if (have) { attn_pv(st, L + A_KV + pslot + 8192, pk, lane); have = false; }
            if (mine) { attn_qk<1>(st, L + A_KV + sl, qr, wsf, biasl, qrow0 - 64 * t, nullptr, lane, pk); have = true; pslot = sl; }
        }
        if (t + 2 <= t_hi) asm volatile("s_waitcnt vmcnt(2)" ::: "memory"); else GLDS_WAIT();
        __syncthreads();
    }
    if (have) attn_pv(st, L + A_KV + pslot + 8192, pk, lane);
    attn_finish(st, wsf, L + A_STG + wid * 4096, Ow, lane);
    __syncthreads();
}

constexpr int B_SCORE = 0, B_MASK = 131072, B_HIST = 147456;
constexpr int B_KV = 0, B_WSF = 156672, B_STG = 0, B_EXP = 147456;
__device__ __forceinline__ unsigned f2u(float f) { const unsigned u = __float_as_uint(f); return (u & 0x80000000u) ? ~u : (u | 0x80000000u); }

__device__ __forceinline__ void select_row_radix(const __attribute__((address_space(3))) float* sc, int limit, __attribute__((address_space(3))) unsigned* hist, __attribute__((address_space(3))) unsigned* mrow, int lane) {
    unsigned prefix = 0u, mask = 0u, kth = 256u;
    for (int shift = 24; shift >= 0; shift -= 8) {
        hist[lane] = 0u; hist[lane + 64] = 0u; hist[lane + 128] = 0u; hist[lane + 192] = 0u;
        asm volatile("s_waitcnt lgkmcnt(0)" ::: "memory");
        for (int i = 4 * lane; i < limit; i += 256) {
            const f32x4 v = *(const __attribute__((address_space(3))) f32x4*)(sc + i);
#pragma unroll
            for (int k = 0; k < 4; ++k) { const unsigned u = f2u(v[k]); if ((u & mask) == prefix) __hip_atomic_fetch_add(&hist[(u >> shift) & 255u], 1u, __ATOMIC_RELAXED, __HIP_MEMORY_SCOPE_WORKGROUP); }
        }
        asm volatile("s_waitcnt lgkmcnt(0)" ::: "memory");
        const v4u h4 = *(const __attribute__((address_space(3))) v4u*)(hist + 4 * lane);
        const unsigned h0 = h4.x, h1 = h4.y, h2 = h4.z, h3 = h4.w;
        const unsigned sl = h0 + h1 + h2 + h3;
        unsigned v = sl;
#pragma unroll
        for (int o = 1; o < 64; o <<= 1) { const unsigned tt = __shfl_down(v, o); if (lane + o < 64) v += tt; }
        const unsigned above = v - sl;
        const bool cross = (above < kth) && (kth <= v);
        unsigned digit = 0u, knew = 0u;
        if (cross) {
            unsigned cum = above;
            if (cum + h3 >= kth) { digit = 4 * lane + 3; knew = kth - cum; }
            else { cum += h3;
                if (cum + h2 >= kth) { digit = 4 * lane + 2; knew = kth - cum; }
                else { cum += h2;
                    if (cum + h1 >= kth) { digit = 4 * lane + 1; knew = kth - cum; }
                    else { cum += h1; digit = 4 * lane; knew = kth - cum; } } }
        }
        const unsigned long long bal = __ballot(cross);
        const int src = (int)__builtin_ctzll(bal | (1ull << 63));
        digit = __shfl(digit, src); kth = __shfl(knew, src);
        prefix |= digit << shift; mask |= 0xFFu << shift;
    }
    unsigned ceq = 0u;
    for (int base = 0; base < limit; base += 256) {
        float vv[4];
#pragma unroll
        for (int k = 0; k < 4; ++k) vv[k] = (base + 64 * k < limit) ? sc[base + 64 * k + lane] : 0.f;
#pragma unroll
        for (int k = 0; k < 4; ++k) {
            if (base + 64 * k < limit) {
                const unsigned u = f2u(vv[k]);
                const bool gt = u > prefix, eq = u == prefix;
                const unsigned long long beq = __ballot(eq);
                const unsigned pre = __builtin_amdgcn_mbcnt_hi((unsigned)(beq >> 32), __builtin_amdgcn_mbcnt_lo((unsigned)beq, 0u));
                const bool sel = gt || (eq && (ceq + pre) < kth);
                const unsigned long long bs = __ballot(sel);
                if (lane == 0) { mrow[(base >> 5) + 2 * k] = (unsigned)bs; mrow[(base >> 5) + 2 * k + 1] = (unsigned)(bs >> 32); }
                ceq += (unsigned)__builtin_popcountll(beq);
            }
        }
    }
}

constexpr int SEL_CAP = 156;
#ifdef SELPROBE
__device__ __forceinline__ int selrep_n(int n) { asm volatile("" : "+s"(n)); return n; }
#define SELREP(N) for (int _rep = 0, _nrep = selrep_n(N); _rep < _nrep; ++_rep)
#define SELREP_FIRST (_rep == 0)
#ifndef SELP_A
#define SELP_A 1
#endif
#ifndef SELP_B
#define SELP_B 1
#endif
#ifndef SELP_C
#define SELP_C 1
#endif
#ifndef SELP_R
#define SELP_R 1
#endif
#ifndef SELP_D
#define SELP_D 1
#endif
#else
#define SELREP(N)
#define SELREP_FIRST true
#endif
__device__ __forceinline__ void select_row(const __attribute__((address_space(3))) float* sc, int limit, __attribute__((address_space(3))) unsigned* scr, __attribute__((address_space(3))) unsigned* mrow, int lane) {
    typedef unsigned u32x2_t __attribute__((ext_vector_type(2)));
    asm volatile("" : "+v"(lane));
    __attribute__((address_space(3))) u32x2_t* list = (__attribute__((address_space(3))) u32x2_t*)(scr + 64);
    float lo = INFINITY, hi = -INFINITY;
    SELREP(SELP_A) {
#pragma unroll 2
    for (int i = 4 * lane; i < limit; i += 256) {
        const f32x4 v = *(const __attribute__((address_space(3))) f32x4*)(sc + i);
        lo = fminf(lo, fminf(fminf(v[0], v[1]), fminf(v[2], v[3]))); hi = fmaxf(hi, fmaxf(fmaxf(v[0], v[1]), fmaxf(v[2], v[3])));
    }
#pragma unroll
    for (int o = 1; o < 64; o <<= 1) { lo = fminf(lo, __shfl_xor(lo, o)); hi = fmaxf(hi, __shfl_xor(hi, o)); }
    }
    if (!(hi > lo)) { select_row_radix(sc, limit, scr, mrow, lane); return; }
    const float scale = 255.99f / (hi - lo);
    scr[lane] = 0u; scr[lane + 64] = 0u; scr[lane + 128] = 0u; scr[lane + 192] = 0u;
    asm volatile("s_waitcnt lgkmcnt(0)" ::: "memory");
    SELREP(SELP_B) {
    const unsigned addv = SELREP_FIRST ? 1u : 0u;
#pragma unroll 2
    for (int i = 4 * lane; i < limit; i += 256) {
        const f32x4 v = *(const __attribute__((address_space(3))) f32x4*)(sc + i);
#pragma unroll
        for (int k = 0; k < 4; ++k) { int bn = (int)((v[k] - lo) * scale); bn = bn > 255 ? 255 : bn; __hip_atomic_fetch_add(&scr[bn], addv, __ATOMIC_RELAXED, __HIP_MEMORY_SCOPE_WORKGROUP); }
    }
    }
    asm volatile("s_waitcnt lgkmcnt(0)" ::: "memory");
    int b1; unsigned kth, c1;
    {
        const v4u h4 = *(const __attribute__((address_space(3))) v4u*)(scr + 4 * lane);
        const unsigned h0 = h4.x, h1 = h4.y, h2 = h4.z, h3 = h4.w, sl = h0 + h1 + h2 + h3;
        unsigned v = sl;
#pragma unroll
        for (int o = 1; o < 64; o <<= 1) { const unsigned tt = __shfl_down(v, o); if (lane + o < 64) v += tt; }
        const unsigned above = v - sl;
        const bool cross = (above < 256u) && (256u <= v);
        unsigned digit = 0u, knew = 0u, cbin = 0u;
        if (cross) {
            unsigned cum = above;
            if (cum + h3 >= 256u) { digit = 4 * lane + 3; knew = 256u - cum; cbin = h3; }
            else { cum += h3;
                if (cum + h2 >= 256u) { digit = 4 * lane + 2; knew = 256u - cum; cbin = h2; }
                else { cum += h2;
                    if (cum + h1 >= 256u) { digit = 4 * lane + 1; knew = 256u - cum; cbin = h1; }
                    else { cum += h1; digit = 4 * lane; knew = 256u - cum; cbin = h0; } } }
        }
        const unsigned long long bal = __ballot(cross);
        const int src = (int)__builtin_ctzll(bal | (1ull << 63));
        b1 = (int)__shfl(digit, src); kth = __shfl(knew, src); c1 = __shfl(cbin, src);
    }
    if (c1 > (unsigned)SEL_CAP) { select_row_radix(sc, limit, scr, mrow, lane); return; }
    b1 = __builtin_amdgcn_readfirstlane(b1); kth = (unsigned)__builtin_amdgcn_readfirstlane((int)kth); c1 = (unsigned)__builtin_amdgcn_readfirstlane((int)c1);
    asm volatile("s_waitcnt lgkmcnt(0)" ::: "memory");
    unsigned cnt = 0u;
#define MXB_SEL_GROUP(VAL, KEY0, W) do { int bn_ = (int)(((VAL) - lo) * scale); bn_ = bn_ > 255 ? 255 : bn_; \
        const unsigned long long gt_ = __ballot(bn_ > b1); const unsigned gl_ = (unsigned)gt_, gh_ = (unsigned)(gt_ >> 32); \
        asm volatile("s_nop 1\n\tv_writelane_b32 %0, %1, " #W "\n\tv_writelane_b32 %0, %2, " #W "+1" : "+v"(mw) : "s"(gl_), "s"(gh_));     \
        const bool mt_ = (bn_ == b1); const unsigned long long bm_ = __ballot(mt_); \
        if (bm_) { if (mt_) { const unsigned pos_ = cnt + __builtin_amdgcn_mbcnt_hi((unsigned)(bm_ >> 32), __builtin_amdgcn_mbcnt_lo((unsigned)bm_, 0u)); list[pos_] = (u32x2_t){~(unsigned)((KEY0) + lane), f2u(VAL)}; } \
            cnt += (unsigned)__builtin_popcountll(bm_); } } while (0)
    {
        unsigned mw = 0u;
        int base = 0;
#pragma unroll 1
        for (; base + 512 <= limit; base += 512) {
            float v[8];
#pragma unroll
            for (int g = 0; g < 8; ++g) v[g] = sc[base + 64 * g + lane];
            MXB_SEL_GROUP(v[0], base, 0); MXB_SEL_GROUP(v[1], base + 64, 2); MXB_SEL_GROUP(v[2], base + 128, 4); MXB_SEL_GROUP(v[3], base + 192, 6);
            MXB_SEL_GROUP(v[4], base + 256, 8); MXB_SEL_GROUP(v[5], base + 320, 10); MXB_SEL_GROUP(v[6], base + 384, 12); MXB_SEL_GROUP(v[7], base + 448, 14);
            if (lane < 16) mrow[(base >> 5) + lane] = mw;
        }
#pragma unroll 1
        for (; base < limit; base += 64) { const float v1 = sc[base + lane]; MXB_SEL_GROUP(v1, base, 0); if (lane < 2) mrow[(base >> 5) + lane] = mw; }
    }
#undef MXB_SEL_GROUP
    if (lane < 4) list[c1 + lane] = (u32x2_t){0u, 0u};
    asm volatile("s_waitcnt lgkmcnt(0)" ::: "memory");
#pragma unroll 1
    for (int c0 = 0; c0 < SEL_CAP; c0 += 64) {
        if ((unsigned)c0 >= c1) break;
        const bool vc = (unsigned)(c0 + lane) < c1;
        u32x2_t e = (u32x2_t){0xFFFFFFFFu, 0xFFFFFFFFu};
        if (vc) e = list[c0 + lane];
        const unsigned long long me = ((unsigned long long)e.y << 32) | e.x;
        unsigned rk = 0u;
        for (unsigned j = 0; j < c1; j += 4) {
            const v4u o0 = *(const __attribute__((address_space(3))) v4u*)(list + j), o1 = *(const __attribute__((address_space(3))) v4u*)(list + j + 2);
            rk += ((((unsigned long long)o0.y << 32) | o0.x) > me) ? 1u : 0u; rk += ((((unsigned long long)o0.w << 32) | o0.z) > me) ? 1u : 0u;
            rk += ((((unsigned long long)o1.y << 32) | o1.x) > me) ? 1u : 0u; rk += ((((unsigned long long)o1.w << 32) | o1.z) > me) ? 1u : 0u;
        }
        if (vc && rk < kth) { const unsigned idx = ~e.x; __hip_atomic_fetch_or(&mrow[idx >> 5], 1u << (idx & 31u), __ATOMIC_RELAXED, __HIP_MEMORY_SCOPE_WORKGROUP); }
    }
}

__device__ __forceinline__ void mixer_b_unit(Frame& F, const bf16* QAB, bf16* OAB, const bf16* KB, const bf16* VB, const bf16* QI, const bf16* KI, const float* WI, int b, int qt) {
    int lane = F.lane; asm volatile("" : "+v"(lane));
    const int wid = F.wave; int r32 = lane & 31, hi = lane >> 5;
    lptr L = F.lds;
    const size_t rowbase = (size_t)b * SEQ; const int q0 = qt * 32, limit = ((q0 >> 6) + 1) * 64;
    __attribute__((address_space(3))) unsigned* maskl = (__attribute__((address_space(3))) unsigned*)(L + B_MASK);
    if (limit <= 256) {
        for (int i = F.tid; i < 32 * 128; i += NWAVES * 64) maskl[i] = ((i & 127) < (limit >> 5)) ? 0xFFFFFFFFu : 0u;
        __syncthreads();
    } else {
        __attribute__((address_space(3))) float* score = (__attribute__((address_space(3))) float*)(L + B_SCORE);
        bf16x8 qa[2][4], qan[2][4]; f32x4 wv[2][4], wvn[2][4];
#define MXB_LOAD_Q(QA, WV, QS0) do { _Pragma("unroll") for (int rt = 0; rt < 2; ++rt) { const size_t qrow = rowbase + (QS0) + 4 * rt + (r32 >> 3); \
            _Pragma("unroll") for (int ks = 0; ks < 4; ++ks) QA[rt][ks] = *(const bf16x8*)(QI + qrow * 512 + (r32 & 7) * 64 + ks * 16 + hi * 8); \
            _Pragma("unroll") for (int qq = 0; qq < 4; ++qq) WV[rt][qq] = *(const f32x4*)(WI + (rowbase + (QS0) + 4 * rt + qq) * 8 + 4 * hi); } } while (0)
        MXB_LOAD_Q(qa, wv, q0);
        bf16x8 kb0[4];
        { const bf16* kp_ = KI + ((size_t)(b * 128 + wid) * 8 + hi) * 256 + r32 * 8;
#pragma unroll
          for (int ks = 0; ks < 4; ++ks) kb0[ks] = *(const bf16x8*)(kp_ + ks * 512); }
        for (int sub = 0; sub < 4; ++sub) {
            float wreg[2][16];
#pragma unroll
            for (int rt = 0; rt < 2; ++rt)
#pragma unroll
                for (int r = 0; r < 16; ++r) wreg[rt][r] = wv[rt][r >> 2][r & 3];
            {
            const int nkt = limit >> 5;
            bf16x8 kb[4], kn[4];
#pragma unroll
            for (int ks = 0; ks < 4; ++ks) kb[ks] = kb0[ks];
#define MXB_IDX_MFMA(ACC, RT, KB) do { _Pragma("unroll") for (int r_ = 0; r_ < 16; ++r_) ACC[r_] = 0.f; \
            _Pragma("unroll") for (int ks_ = 0; ks_ < 4; ++ks_) ACC = __builtin_amdgcn_mfma_f32_32x32x16_bf16(qa[RT][ks_], KB[ks_], ACC, 0, 0, 0); } while (0)
#define MXB_IDX_EPI(ACC, RT, KT) do { float part_[4]; \
            _Pragma("unroll") for (int qq_ = 0; qq_ < 4; ++qq_) { float pp_ = 0.f; \
                _Pragma("unroll") for (int i_ = 0; i_ < 4; ++i_) { const float av_ = ACC[4 * qq_ + i_]; const int xb_ = __float_as_int(av_); pp_ += wreg[RT][4 * qq_ + i_] * __int_as_float(xb_ > 0 ? xb_ : 0); } \
                part_[qq_] = pp_; } \
              \
            const auto s02_ = __builtin_amdgcn_permlane32_swap(__float_as_uint(part_[0]), __float_as_uint(part_[2]), false, false); \
            const auto s13_ = __builtin_amdgcn_permlane32_swap(__float_as_uint(part_[1]), __float_as_uint(part_[3]), false, false); \
            const float v0_ = __uint_as_float(s02_[0]) + __uint_as_float(s02_[1]), v1_ = __uint_as_float(s13_[0]) + __uint_as_float(s13_[1]); \
            score[(4 * (RT) + 2 * hi) * limit + 32 * (KT) + r32] = v0_ + 0.0f; \
            score[(4 * (RT) + 2 * hi + 1) * limit + 32 * (KT) + r32] = v1_ + 0.0f; } while (0)
            {
                f32x16 a0, a1;
                int kt = wid;
#define MXB_IDX_SCHED() do { _Pragma("unroll") for (int g_ = 0; g_ < 4; ++g_) { __builtin_amdgcn_sched_group_barrier(0x008, 1, 0); __builtin_amdgcn_sched_group_barrier(0x002, 11, 0); } \
                __builtin_amdgcn_sched_barrier(0); } while (0)
#define MXB_IDX_LOADK(KD, KT_) do { const bf16* kp_ = KI + ((size_t)(b * 128 + (KT_)) * 8 + hi) * 256 + r32 * 8; \
                _Pragma("unroll") for (int ks = 0; ks < 4; ++ks) KD[ks] = *(const bf16x8*)(kp_ + ks * 512); } while (0)
#define MXB_IDX_TRIP(K0, K1) do { \
                MXB_IDX_MFMA(a1, 1, K0); MXB_IDX_EPI(a0, 0, kt); MXB_IDX_SCHED(); \
                MXB_IDX_LOADK(K0, (kt + 2 * NWAVES < nkt) ? kt + 2 * NWAVES : wid); \
                MXB_IDX_MFMA(a0, 0, K1);   \
                MXB_IDX_EPI(a1, 1, kt); MXB_IDX_SCHED(); } while (0)
                MXB_IDX_LOADK(kn, (kt + NWAVES < nkt) ? kt + NWAVES : kt);
                MXB_IDX_MFMA(a0, 0, kb);
                for (;;) {
                    MXB_IDX_TRIP(kb, kn);
                    if (kt + NWAVES >= nkt) break;
                    kt += NWAVES;
                    MXB_IDX_TRIP(kn, kb);
                    if (kt + NWAVES >= nkt) break;
                    kt += NWAVES;
                }
            }
#undef MXB_IDX_TRIP
#undef MXB_IDX_SCHED
#undef MXB_IDX_LOADK
#undef MXB_IDX_MFMA
#undef MXB_IDX_EPI
            }
            if (sub < 3) MXB_LOAD_Q(qan, wvn, q0 + 8 * (sub + 1));
            __syncthreads();
            select_row(score + wid * limit, limit, (__attribute__((address_space(3))) unsigned*)(L + B_HIST) + wid * 384, maskl + (8 * sub + wid) * 128, lane);
            __syncthreads();
#pragma unroll
            for (int rt = 0; rt < 2; ++rt) {
#pragma unroll
                for (int ks = 0; ks < 4; ++ks) qa[rt][ks] = qan[rt][ks];
#pragma unroll
                for (int qq = 0; qq < 4; ++qq) wv[rt][qq] = wvn[rt][qq];
            }
        }
    }
    asm volatile("" : "+v"(lane)); r32 = lane & 31; hi = lane >> 5;
    const int h = wid, g = wid >> 2;
    __attribute__((address_space(3))) float* wsf = (__attribute__((address_space(3))) float*)(L + B_WSF) + wid * 64;
    const bf16* Qw = QAB + (rowbase + q0) * 1024 + 512 + h * 64; bf16* Ow = OAB + (rowbase + q0) * 1024 + 512 + h * 64;
    bf16x8 qr[4];
#pragma unroll
    for (int d0 = 0; d0 < 4; ++d0) qr[d0] = *(const bf16x8*)(Qw + (size_t)r32 * 1024 + d0 * 16 + hi * 8);
    const int nt = limit >> 6;
    const bf16* kvsrc = KB + (size_t)(b * 64) * 16384 + wid * 512 + lane * 8;
    const int pdst = wid * 1024;
    {
    glds16(kvsrc, L + B_KV + pdst); glds16(kvsrc + 4096, L + B_KV + 8192 + pdst); glds16(kvsrc + 8192, L + B_KV + 16384 + pdst); glds16(kvsrc + 12288, L + B_KV + 24576 + pdst);
    if (nt > 1) { const size_t adv = (size_t)16384; lptr nb = L + B_KV + 32768 + pdst;
        glds16(kvsrc + adv, nb); glds16(kvsrc + adv + 4096, nb + 8192); glds16(kvsrc + adv + 8192, nb + 16384); glds16(kvsrc + adv + 12288, nb + 24576); }
    expand_pair_masks(maskl, L + B_EXP, 0, F.tid);
    if (nt > 1) asm volatile("s_waitcnt vmcnt(4)" ::: "memory"); else GLDS_WAIT();
    __syncthreads();
    AttnState st; st.m = 0.f; st.l = 0.f; st.first = true;
#pragma unroll
    for (int r = 0; r < 16; ++r) { st.o0[r] = 0.f; st.o1[r] = 0.f; }
    const bool late = false; PK pk; bool have = false;
    for (int t = 0; t < nt; ++t) {
        const int cur = t & 1, sl = (t & 3) * 32768;
        const auto dma = [&]() { if (t + 2 < nt) { const size_t adv = (size_t)(t + 2) * 16384; lptr nb = L + B_KV + ((t + 2) & 3) * 32768 + pdst;
            glds16(kvsrc + adv, nb); glds16(kvsrc + adv + 4096, nb + 8192); glds16(kvsrc + adv + 8192, nb + 16384); glds16(kvsrc + adv + 12288, nb + 24576); } };
        if (t + 1 < nt) expand_pair_masks(maskl, L + B_EXP + (cur ^ 1) * 4608, t + 1, F.tid);
        if (!late) { attn_qk<2>(st, L + B_KV + sl + g * 8192, qr, wsf, nullptr, 0, L + B_EXP + cur * 4608, lane, pk, dma); attn_pv(st, L + B_KV + sl + 16384 + g * 8192, pk, lane); }
        else {
            if (have) attn_pv(st, L + B_KV + ((t - 1) & 3) * 32768 + 16384 + g * 8192, pk, lane);
            attn_qk<2>(st, L + B_KV + sl + g * 8192, qr, wsf, nullptr, 0, L + B_EXP + cur * 4608, lane, pk); have = true;
        }
        if (t + 2 < nt) asm volatile("s_waitcnt vmcnt(4)" ::: "memory"); else GLDS_WAIT();
        __syncthreads();
    }
    if (late) attn_pv(st, L + B_KV + ((nt - 1) & 3) * 32768 + 16384 + g * 8192, pk, lane);
    __syncthreads();
    attn_finish(st, wsf, L + B_STG + wid * 4096, Ow, lane);
    __syncthreads();
    }
}

__device__ __forceinline__ void mixer_phase(Frame& F, const Args& a, unsigned char* R) {
    const bf16* QAB = (const bf16*)(R + R_QAB); bf16* OAB = (bf16*)a.out;
    for (int c = (int)blockIdx.x; c < 256; c += F.G) {
        { const int h = c & 7, b = (c >> 3) & 3, s = c >> 5;
#pragma unroll 1
          for (int i = 0; i < 2; ++i) mixer_a_unit(F, QAB, OAB, (const bf16*)(R + R_KA), (const bf16*)(R + R_VA), a.in[6], b, (i & 1) ? 15 - s : s, h); }
        { const int x = c & 7, b = x >> 1, s = ((c >> 3) << 1) | (x & 1);
#pragma unroll 1
          for (int i = 0; i < 2; ++i) mixer_b_unit(F, QAB, OAB, (const bf16*)(R + R_KB), (const bf16*)(R + R_VB), (const bf16*)(R + R_QI), (const bf16*)(R + R_KI), (const float*)(R + R_WI), b, i ? 127 - s : s); }
    }
}
}

__global__ void __launch_bounds__(NWAVES * 64, 2) mk_fwd(Args args) {
    extern __shared__ __attribute__((aligned(16))) unsigned char lds[];
    Frame F;
    F.lds = (LAS unsigned char*)lds;
    F.MISC = (volatile LAS unsigned*)(F.lds + MISC_OFF);
    F.tid = threadIdx.x; F.lane = F.tid & 63; F.wave = __builtin_amdgcn_readfirstlane(F.tid >> 6);
    F.G = gridDim.x; { const int bx = blockIdx.x; F.vcu = (F.G % 8 == 0) ? (bx % 8) * (F.G / 8) + bx / 8 : bx; }
    unsigned char* ws = args.ws;
    F.ctl = (gu32*)(ws + WS_CTL);
    for (int u = F.tid; u < (LDS_BYTES - LDSCTL_OFF) / 4; u += NWAVES * 64) ((LAS unsigned*)(F.lds + LDSCTL_OFF))[u] = 0u;
    __syncthreads();
    XcdBarrier bar = xcd_barrier_post((unsigned*)(F.ctl + CW_BAR), F.MISC + 8);
    const int lo = args.ph_lo, hi = args.ph_hi;
#define IN(k) (lo <= (k) && (k) < hi)
#define BOTH(k) (IN(k) && IN((k) + 1))
#define GRID_BAR() xcd_barrier(bar)
    bf16* XB = (bf16*)(ws + WS_XB); float* SSQ = (float*)(ws + WS_SSQ); unsigned char* R = ws + WS_R;
    constexpr size_t SSQ_STRIDE = (size_t)M * 16;

    if (IN(0)) { p0_prologue(F, args); if (BOTH(0)) GRID_BAR(); }
    if (IN(1)) {
        pg8::Gemm g{XB, (const bf16*)(ws + WS_W1), M, 2 * FF, D}; pg8::StaticOrder S; S.init(M, 2 * FF, F.G, (int)blockIdx.x);
        const int rpm = fill_rstd_table(F, SSQ, S);
        pg8::EpiSwiglu E{(bf16*)R, SSQ, (const LAS float*)(F.lds + RSTD_OFF), rpm};
        pg8::gemm_phase<pg8::EpiSwiglu, pg8::StaticOrder, true, true>(F.lds + RING_OFF, g, S, E);
        if (tail_convert(F) && (int)blockIdx.x >= 128) convert_weights(F, args, 1, ((int)blockIdx.x - 128) * NWAVES + F.wave, 128 * NWAVES);
        if (BOTH(1)) GRID_BAR();
    }
    if (IN(2)) {
        pg8::Gemm g{(const bf16*)R, (const bf16*)(ws + WS_W2), M, D, FF}; pg8::StaticOrder S; S.init(M, D, F.G, (int)blockIdx.x);
        pg8::EpiResid E{nullptr, XB, XB, SSQ + SSQ_STRIDE, 0.5f};
        pg8::gemm_phase<pg8::EpiResid, pg8::StaticOrder, true, true>(F.lds + RING_OFF, g, S, E);
        if (BOTH(2)) GRID_BAR();
    }
    if (IN(3)) {
        pg8::Gemm g{XB, (const bf16*)(ws + WS_WIN), M, NPROJ, D}; pg8::StaticOrder S; S.init(M, NPROJ, F.G, (int)blockIdx.x);
        pg8::ProjOut po{(bf16*)(R + R_QAB), (bf16*)(R + R_KA), (bf16*)(R + R_VA), (bf16*)(R + R_KB), (bf16*)(R + R_VB), (bf16*)(R + R_QI), (bf16*)(R + R_KI), (float*)(R + R_WI), (bf16*)(R + R_RAT), (bf16*)(R + R_SGB), (const float*)(ws + WS_ROPE)};
        const int rpm = fill_rstd_table(F, SSQ + SSQ_STRIDE, S);
        pg8::EpiProj E{po, SSQ + SSQ_STRIDE, (const LAS float*)(F.lds + RSTD_OFF), rpm};
        pg8::gemm_phase<pg8::EpiProj, pg8::StaticOrder, true, true>(F.lds + RING_OFF, g, S, E);
        if (BOTH(3)) GRID_BAR();
    }
    if (IN(4)) {
        mx::mixer_phase(F, args, R);
        if (BOTH(4)) GRID_BAR();
    }
    if (IN(5)) {
        pg8::Gemm g{(const bf16*)args.out, (const bf16*)(ws + WS_WAB), M, D, D}; pg8::StaticOrder S; S.init(M, D, F.G, (int)blockIdx.x);
        pg8::EpiGate E{(const bf16*)(R + R_RAT), (const bf16*)(R + R_SGB), (bf16*)(R + R_MG)};
        pg8::gemm_phase<pg8::EpiGate, pg8::StaticOrder, true, true>(F.lds + RING_OFF, g, S, E);
        if (BOTH(5)) GRID_BAR();
    }
    if (IN(6)) {
        pg8::Gemm g{(const bf16*)(R + R_MG), (const bf16*)(ws + WS_WO), M, D, D}; pg8::StaticOrder S; S.init(M, D, F.G, (int)blockIdx.x);
        pg8::EpiResid E{nullptr, XB, XB, SSQ + 2 * SSQ_STRIDE, 1.0f};
        pg8::gemm_phase<pg8::EpiResid, pg8::StaticOrder, true, true>(F.lds + RING_OFF, g, S, E);
        if (BOTH(6)) GRID_BAR();
    }
    if (IN(7)) {
        pg8::Gemm g{XB, (const bf16*)(ws + WS_W3), M, 2 * FF, D}; pg8::StaticOrder S; S.init(M, 2 * FF, F.G, (int)blockIdx.x);
        const int rpm = fill_rstd_table(F, SSQ + 2 * SSQ_STRIDE, S);
        pg8::EpiSwiglu E{(bf16*)R, SSQ + 2 * SSQ_STRIDE, (const LAS float*)(F.lds + RSTD_OFF), rpm};
        pg8::gemm_phase<pg8::EpiSwiglu, pg8::StaticOrder, true, true>(F.lds + RING_OFF, g, S, E);
        if (tail_convert(F) && (int)blockIdx.x >= 128) convert_weights(F, args, 2, ((int)blockIdx.x - 128) * NWAVES + F.wave, 128 * NWAVES);
        if (BOTH(7)) GRID_BAR();
    }
    if (IN(8) && IN(9) && F.G == 256) {
        pg8::Gemm g{(const bf16*)R, (const bf16*)(ws + WS_W4), M, D, FF}; pg8::StaticOrder S; S.init(M, D, F.G, (int)blockIdx.x);
        pg8::EpiFinal E{XB, args.out, SSQ + 3 * SSQ_STRIDE, args.in[13], 0.5f, &bar};
        pg8::gemm_phase<pg8::EpiFinal, pg8::StaticOrder, false, true>(F.lds + RING_OFF, g, S, E);
    } else {
    if (IN(8)) {
        pg8::Gemm g{(const bf16*)R, (const bf16*)(ws + WS_W4), M, D, FF}; pg8::StaticOrder S; S.init(M, D, F.G, (int)blockIdx.x);
        pg8::EpiResidF E{XB, args.out, SSQ + 3 * SSQ_STRIDE, 0.5f};
        pg8::gemm_phase<pg8::EpiResidF, pg8::StaticOrder, true, true>(F.lds + RING_OFF, g, S, E);
        if (BOTH(8)) GRID_BAR();
    }
    if (IN(9)) p9_final(F, args.out, SSQ + 3 * SSQ_STRIDE, args.in[13]);
    }
#undef IN
#undef BOTH
#undef GRID_BAR
}

static int mk_grid() {
    static int grid = 0;
    if (grid == 0) {
        int dev = 0, cus = 0, per_cu = 0;
        if (hipGetDevice(&dev) != hipSuccess || hipDeviceGetAttribute(&cus, hipDeviceAttributeMultiprocessorCount, dev) != hipSuccess) { fprintf(stderr, "kernel_launch: device query failed\n"); grid = -1; return grid; }
        if (hipFuncSetAttribute((const void*)mk_fwd, hipFuncAttributeMaxDynamicSharedMemorySize, LDS_BYTES) != hipSuccess) { fprintf(stderr, "kernel_launch: hipFuncSetAttribute failed\n"); grid = -1; return grid; }
        if (hipOccupancyMaxActiveBlocksPerMultiprocessor(&per_cu, (const void*)mk_fwd, NWAVES * 64, LDS_BYTES) != hipSuccess || per_cu < 1) { fprintf(stderr, "kernel_launch: occupancy query reports %d blocks per CU\n", per_cu); per_cu = 1; }
        (void)hipGetLastError();
        grid = cus;
    }
    return grid;
}
extern "C" void kernel_launch(void* const* d_in, const int* in_sizes, int n_in, void* d_out, int out_size, void* d_ws, size_t ws_size, hipStream_t stream) {
    const int grid = mk_grid();
    if (grid < 0) return;
    unsigned char* ws = (unsigned char*)d_ws;
    Args a{};
    for (int i = 0; i < 14; ++i) a.in[i] = (const float*)d_in[i];
    a.out = (float*)d_out; a.ws = ws;
    (void)hipMemsetAsync(ws + WS_CTL, 0, CTL_ZERO_BYTES, stream);
    a.ph_lo = 0; a.ph_hi = 10;
    hipLaunchKernelGGL(mk_fwd, dim3(grid), dim3(NWAVES * 64), LDS_BYTES, stream, a);
}
```
